# Optimizing an MI355X kernel written in HIP

```python
import math
import jax, jax.numpy as jnp
from jax import lax
import numpy as np

D_MODEL = 2048
BATCH = 4
SEQ = 4096
DEPTH = 2

N_A_LAYERS = DEPTH // 2
N_B_LAYERS = DEPTH - N_A_LAYERS
CONV_WIDTH = 3
D_FF = ((8 * D_MODEL // 3 + 255) // 256) * 256
DIFF_HEADS = D_MODEL // 256
DIFF_HEAD_DIM = D_MODEL // DIFF_HEADS // 2
V_HEAD_DIM = 2 * DIFF_HEAD_DIM
QK_WIDTH = DIFF_HEADS * 2 * DIFF_HEAD_DIM
V_WIDTH = DIFF_HEADS * V_HEAD_DIM
ROT_DIM = DIFF_HEAD_DIM // 4
ROPE_THETA = 500000.0
Q_BLOCK = 128
DEEPNORM_ALPHA = (2.0 * DEPTH) ** 0.25
DEEPNORM_BETA = (8.0 * DEPTH) ** -0.25
LN_EPS = 1e-5
SUBLN_EPS = 1e-5

kernel_name = 'hybrid_shortconv_yoco_diffattn_convffn_deepnorm'


def causal_dwconv(x, w):
    s = x.shape[1]
    xp = jnp.pad(x, ((0, 0), (CONV_WIDTH - 1, 0), (0, 0)))
    y = xp[:, 0:s] * w[0]
    for j in range(1, CONV_WIDTH):
        y = y + xp[:, j:j + s] * w[j]
    return y


def layer_norm(x, g, b):
    xf = x.astype(jnp.float32)
    mu = jnp.mean(xf, axis=-1, keepdims=True)
    var = jnp.mean(jnp.square(xf - mu), axis=-1, keepdims=True)
    y = (xf - mu) * lax.rsqrt(var + LN_EPS)
    return (y * g.astype(jnp.float32) + b.astype(jnp.float32)).astype(x.dtype)


def rms_norm(x, g):
    xf = x.astype(jnp.float32)
    y = xf * lax.rsqrt(jnp.mean(jnp.square(xf), axis=-1, keepdims=True) + SUBLN_EPS)
    return (y * g.astype(jnp.float32)).astype(x.dtype)


def rope_tables(positions):
    inv_freq = ROPE_THETA ** (-jnp.arange(0, ROT_DIM, 2, dtype=jnp.float32) / ROT_DIM)
    ang = positions.astype(jnp.float32)[..., None] * inv_freq
    return jnp.cos(ang), jnp.sin(ang)


def partial_rope(t, cos, sin):
    half = ROT_DIM // 2
    rot = t[..., :ROT_DIM].astype(jnp.float32)
    x1, x2 = rot[..., :half], rot[..., half:]
    c = cos[:, :, None, None, :]
    s = sin[:, :, None, None, :]
    rotated = jnp.concatenate([x1 * c - x2 * s, x2 * c + x1 * s], axis=-1).astype(t.dtype)
    return jnp.concatenate([rotated, t[..., ROT_DIM:]], axis=-1)


def short_conv_mixer(x, w_in, conv_w, w_out):
    b_gate, c_gate, xv = jnp.split(x @ w_in, 3, axis=-1)
    y = b_gate * causal_dwconv(c_gate * xv, conv_w)
    return y @ w_out


def conv_ffn(x, w_up, conv_w, conv_b, w_down):
    h = causal_dwconv(x @ w_up, conv_w) + conv_b
    g, u = jnp.split(h, 2, axis=-1)
    return (jax.nn.silu(g) * u) @ w_down


def shared_kv(x, w_k, w_v, cos, sin):
    bsz, s, _ = x.shape
    k = partial_rope((x @ w_k).reshape(bsz, s, DIFF_HEADS, 2, DIFF_HEAD_DIM), cos, sin)
    v = (x @ w_v).reshape(bsz, s, DIFF_HEADS, V_HEAD_DIM)
    return k, v


def diff_attention(x, k, v, cos, sin, w_q, lam, subln_g, w_o, lambda_init):
    bsz, s, _ = x.shape
    q = (x @ w_q).reshape(bsz, s, DIFF_HEADS, 2, DIFF_HEAD_DIM)
    q = partial_rope(q, cos, sin) * (DIFF_HEAD_DIM ** -0.5)
    lamf = lam.astype(jnp.float32)
    lam_full = (jnp.exp(jnp.sum(lamf[0] * lamf[1])) - jnp.exp(jnp.sum(lamf[2] * lamf[3]))
                + lambda_init)
    kpos = jnp.arange(s)
    neg = jnp.finfo(jnp.float32).min

    def block(i):
        start = i * Q_BLOCK
        qb = lax.dynamic_slice_in_dim(q, start, Q_BLOCK, axis=1)
        sc = jnp.einsum('bqhcd,bkhcd->bhcqk', qb, k).astype(jnp.float32)
        qpos = start + jnp.arange(Q_BLOCK)
        mask = kpos[None, :] <= qpos[:, None]
        p = jax.nn.softmax(jnp.where(mask, sc, neg), axis=-1)
        a = p[:, :, 0] - lam_full * p[:, :, 1]
        return jnp.einsum('bhqk,bkhe->bqhe', a.astype(v.dtype), v)

    o = lax.map(block, jnp.arange(s // Q_BLOCK))
    o = jnp.moveaxis(o, 0, 1).reshape(bsz, s, DIFF_HEADS, V_HEAD_DIM)
    o = rms_norm(o, subln_g) * (1.0 - lambda_init)
    return o.reshape(bsz, s, V_WIDTH) @ w_o


def setup_inputs(seed: int = 0) -> dict:
    key = jax.random.key(seed)
    ks = jax.random.split(key, 16)
    f32 = jnp.float32
    nrm = lambda k, shape: jax.random.normal(k, shape, dtype=f32)
    x = nrm(ks[0], (BATCH, SEQ, D_MODEL))
    positions = jnp.broadcast_to(jnp.arange(SEQ, dtype=jnp.int32), (BATCH, SEQ))
    ln_g = 1.0 + 0.02 * nrm(ks[1], (DEPTH, 2, D_MODEL))
    ln_b = 0.02 * nrm(ks[2], (DEPTH, 2, D_MODEL))
    a_w_in = nrm(ks[3], (N_A_LAYERS, D_MODEL, 3 * D_MODEL)) * D_MODEL ** -0.5
    a_conv_w = nrm(ks[4], (N_A_LAYERS, CONV_WIDTH, D_MODEL)) * CONV_WIDTH ** -0.5
    a_w_out = nrm(ks[5], (N_A_LAYERS, D_MODEL, D_MODEL)) * (D_MODEL ** -0.5 * DEEPNORM_BETA)
    kv_w_k = nrm(ks[6], (D_MODEL, QK_WIDTH)) * D_MODEL ** -0.5
    kv_w_v = nrm(ks[7], (D_MODEL, V_WIDTH)) * (D_MODEL ** -0.5 * DEEPNORM_BETA)
    b_w_q = nrm(ks[8], (N_B_LAYERS, D_MODEL, QK_WIDTH)) * D_MODEL ** -0.5
    b_lambda = 0.1 * nrm(ks[9], (N_B_LAYERS, 4, DIFF_HEAD_DIM))
    b_subln_g = 1.0 + 0.02 * nrm(ks[10], (N_B_LAYERS, V_HEAD_DIM))
    b_w_o = nrm(ks[11], (N_B_LAYERS, V_WIDTH, D_MODEL)) * (V_WIDTH ** -0.5 * DEEPNORM_BETA)
    ffn_w_up = nrm(ks[12], (DEPTH, D_MODEL, 2 * D_FF)) * D_MODEL ** -0.5
    ffn_conv_w = nrm(ks[13], (DEPTH, CONV_WIDTH, 2 * D_FF)) * CONV_WIDTH ** -0.5
    ffn_conv_b = 0.02 * nrm(ks[14], (DEPTH, 2 * D_FF))
    ffn_w_down = nrm(ks[15], (DEPTH, D_FF, D_MODEL)) * (D_FF ** -0.5 * DEEPNORM_BETA)
    return {'x': x, 'positions': positions, 'ln_g': ln_g, 'ln_b': ln_b,
            'a_w_in': a_w_in, 'a_conv_w': a_conv_w, 'a_w_out': a_w_out,
            'kv_w_k': kv_w_k, 'kv_w_v': kv_w_v,
            'b_w_q': b_w_q, 'b_lambda': b_lambda, 'b_subln_g': b_subln_g, 'b_w_o': b_w_o,
            'ffn_w_up': ffn_w_up, 'ffn_conv_w': ffn_conv_w, 'ffn_conv_b': ffn_conv_b,
            'ffn_w_down': ffn_w_down}


def reference(x, positions, ln_g, ln_b, a_w_in, a_conv_w, a_w_out, kv_w_k, kv_w_v,
              b_w_q, b_lambda, b_subln_g, b_w_o, ffn_w_up, ffn_conv_w, ffn_conv_b,
              ffn_w_down):
    cos, sin = rope_tables(positions)
    k_sh, v_sh = None, None
    for layer in range(DEPTH):
        if layer < N_A_LAYERS:
            mix = short_conv_mixer(x, a_w_in[layer], a_conv_w[layer], a_w_out[layer])
        else:
            j = layer - N_A_LAYERS
            if j == 0:
                k_sh, v_sh = shared_kv(x, kv_w_k, kv_w_v, cos, sin)
            lambda_init = 0.8 - 0.6 * math.exp(-0.3 * layer)
            mix = diff_attention(x, k_sh, v_sh, cos, sin, b_w_q[j], b_lambda[j],
                                 b_subln_g[j], b_w_o[j], lambda_init)
        x = layer_norm(DEEPNORM_ALPHA * x + mix, ln_g[layer, 0], ln_b[layer, 0])
        ffn = conv_ffn(x, ffn_w_up[layer], ffn_conv_w[layer], ffn_conv_b[layer], ffn_w_down[layer])
        x = layer_norm(DEEPNORM_ALPHA * x + ffn, ln_g[layer, 1], ln_b[layer, 1])
    return x
```

```cpp
#include <hip/hip_runtime.h>
#include <hip/hip_bf16.h>
#include <hip/hip_cooperative_groups.h>
#include <cstdio>
#include <cstdint>
namespace cg = cooperative_groups;

extern __shared__ __attribute__((aligned(16))) unsigned char g_lds[];
constexpr int WTAB_OFF = 131072 + 16;
__device__ __forceinline__ int olane() { int l; asm volatile("v_mbcnt_lo_u32_b32 %0, -1, 0\n\tv_mbcnt_hi_u32_b32 %0, -1, %0" : "=v"(l)); return l; }
template <int M> __device__ __forceinline__ float swz_xor(float v, int lane) { return __builtin_bit_cast(float, __builtin_amdgcn_ds_bpermute((lane ^ M) << 2, __builtin_bit_cast(int, v))); }
template <int M> __device__ __forceinline__ float xadd(float v, int lane) { return v + swz_xor<M>(v, lane); }
__device__ __forceinline__ float wsum64(float v, int lane) { v = xadd<1>(v, lane); v = xadd<2>(v, lane); v = xadd<4>(v, lane); v = xadd<8>(v, lane); v = xadd<16>(v, lane); return xadd<32>(v, lane); }
__device__ __forceinline__ unsigned hwslot() { return (unsigned)__builtin_amdgcn_s_getreg((5 << 11) | 4) & 63u; }
__device__ __forceinline__ int otid() {
    const int wid = __builtin_amdgcn_readfirstlane(((volatile __attribute__((address_space(3))) int*)(g_lds + WTAB_OFF))[hwslot()]);
    return wid * 64 + olane();
}
#ifndef PG8_ALIGN
#define PG8_ALIGN true
#endif
#ifndef PG8_SP2
#define PG8_SP2 true
#endif
namespace pg8 {
#define PG8_LAS __attribute__((address_space(3)))
typedef unsigned short bf16_t;
typedef short bf16x8 __attribute__((ext_vector_type(8)));
typedef float f32x4 __attribute__((ext_vector_type(4)));
typedef unsigned u32x4 __attribute__((ext_vector_type(4)));
constexpr int BM = 256, BK = 64, HALF = 128, HTB = HALF * BK * 2  , STAGE_BYTES = 8 * HTB, NXCD = 8, WGM = 8;

__host__ __device__ __forceinline__ int lds_byte(int r, int c) { const int st = (r >> 4) * 2 + (c >> 5), rr = r & 15, cc = c & 31, ob = rr * 64 + cc * 2; return st * 1024 + (ob ^ (((ob >> 9) & 1) << 5)); }
__host__ __device__ __forceinline__ void stage_rc(int b, int& R, int& C) { const int st = b / 1024, sb = b % 1024, swz = sb ^ (((sb >> 9) & 1) << 5); R = (st >> 1) * 16 + swz / 64; C = (st & 1) * 32 + (swz % 64) / 2; }
__host__ __device__ __forceinline__ int perm32(int rho) { const int n = rho >> 4, i = rho & 15; return 8 * (i >> 2) + 4 * n + (i & 3); }

struct Unit { int pm, pn; };
struct Gemm { const bf16_t* A; const bf16_t* Bt; int M, N, K; };

struct StaticOrder {
    int nM, nN, nwg, G, c;
    __host__ __device__ void init(int M, int N, int G_, int c_) { nM = M / BM; nN = N / BM; nwg = nM * nN; G = G_; c = c_; }
    __host__ __device__ bool next(int i, Unit& u) const {
        const long L = (long)i * G + c; if (L >= nwg) return false;
        int wgid = (int)L; { const int q = nwg / NXCD, r = nwg % NXCD, xcd = wgid % NXCD, off = wgid / NXCD; wgid = (xcd < r ? xcd * (q + 1) : r * (q + 1) + (xcd - r) * q) + off; }
        const int nig = WGM * nN, gid = wgid / nig, fm = gid * WGM, gsz = (nM - fm) < WGM ? (nM - fm) : WGM;
        u.pm = fm + ((wgid % nig) % gsz); u.pn = (wgid % nig) / gsz; return true;
    }
    __device__ __forceinline__ void a_ready(const Unit&) const {}
    __device__ __forceinline__ void done(const Unit&) const {}
};
__device__ __forceinline__ unsigned cvt_pk_bf16(float lo, float hi) { unsigned r; asm volatile("v_cvt_pk_bf16_f32 %0, %1, %2" : "=v"(r) : "v"(lo), "v"(hi)); return r; }
typedef unsigned u32x2 __attribute__((ext_vector_type(2)));
typedef float f32x2 __attribute__((ext_vector_type(2)));
struct EpiBf16P {
    static constexpr bool PERM = true, AFTER_DRAIN = false;
    bf16_t* O; int ldc;
    const float* rcos; const float* rsin;
    static __device__ __forceinline__ float pull(int addr, float v) { return __builtin_bit_cast(float, __builtin_amdgcn_ds_bpermute(addr, __builtin_bit_cast(int, v))); }
    __device__ __forceinline__ void operator()(const f32x4 (&acc)[2][2][4][2], const Unit& u, int wr, int wc, int fr, int fq) const {
        const int row0 = u.pm * BM + wr * 64 + fr, col0 = u.pn * BM + wc * 32 + 8 * fq;
        const bool rope = rcos != nullptr && wc == 0 && u.pn < 16;
        const int plane = ((fq * 16 + fr) ^ 32) << 2; const float sgn = fq < 2 ? -1.f : 1.f;
#pragma unroll
        for (int ai = 0; ai < 2; ++ai)
#pragma unroll
            for (int m = 0; m < 4; ++m) { const int row = row0 + ai * HALF + m * 16; bf16_t* rowp = O + (size_t)row * ldc + col0;
                f32x4 c0, c1, s0, s1;
                if (rope) { const float* cp = rcos + (size_t)row * 16 + 8 * (fq & 1); const float* sp = rsin + (size_t)row * 16 + 8 * (fq & 1);
                    c0 = *(const f32x4*)cp; c1 = *(const f32x4*)(cp + 4); s0 = *(const f32x4*)sp * sgn; s1 = *(const f32x4*)(sp + 4) * sgn; }
#pragma unroll
                for (int bj = 0; bj < 2; ++bj) { f32x4 v0 = acc[ai][bj][m][0], v1 = acc[ai][bj][m][1];
                    if (rope) { f32x4 p0, p1;
                        p0[0] = pull(plane, v0[0]); p0[1] = pull(plane, v0[1]); p0[2] = pull(plane, v0[2]); p0[3] = pull(plane, v0[3]);
                        p1[0] = pull(plane, v1[0]); p1[1] = pull(plane, v1[1]); p1[2] = pull(plane, v1[2]); p1[3] = pull(plane, v1[3]);
                        v0 = v0 * c0 + p0 * s0; v1 = v1 * c1 + p1 * s1; }
                    u32x4 w; w.x = cvt_pk_bf16(v0[0], v0[1]); w.y = cvt_pk_bf16(v0[2], v0[3]); w.z = cvt_pk_bf16(v1[0], v1[1]); w.w = cvt_pk_bf16(v1[2], v1[3]);
                    *(u32x4*)(rowp + bj * HALF) = w; } }
    }
};
struct EpiGateCV {
    static constexpr bool PERM = true, AFTER_DRAIN = false;
    bf16_t* Bq; bf16_t* CV;
    __device__ __forceinline__ void operator()(const f32x4 (&acc)[2][2][4][2], const Unit& u, int wr, int wc, int fr, int fq) const {
        const int row0 = u.pm * BM + wr * 64 + fr;
        if (u.pn < 16) {
            const int c0 = u.pn * 128 + wc * 32 + 8 * fq;
#pragma unroll
            for (int ai = 0; ai < 2; ++ai)
#pragma unroll
                for (int m = 0; m < 4; ++m) { const f32x4 v0 = acc[ai][0][m][0] * acc[ai][1][m][0], v1 = acc[ai][0][m][1] * acc[ai][1][m][1];
                    u32x4 w; w.x = cvt_pk_bf16(v0[0], v0[1]); w.y = cvt_pk_bf16(v0[2], v0[3]); w.z = cvt_pk_bf16(v1[0], v1[1]); w.w = cvt_pk_bf16(v1[2], v1[3]);
                    *(u32x4*)(CV + (size_t)(row0 + ai * HALF + m * 16) * 2048 + c0) = w; }
        } else {
            const int c0 = (u.pn - 16) * BM + wc * 32 + 8 * fq;
#pragma unroll
            for (int ai = 0; ai < 2; ++ai)
#pragma unroll
                for (int m = 0; m < 4; ++m) { bf16_t* rowp = Bq + (size_t)(row0 + ai * HALF + m * 16) * 2048 + c0;
#pragma unroll
                    for (int bj = 0; bj < 2; ++bj) { const f32x4 v0 = acc[ai][bj][m][0], v1 = acc[ai][bj][m][1];
                        u32x4 w; w.x = cvt_pk_bf16(v0[0], v0[1]); w.y = cvt_pk_bf16(v0[2], v0[3]); w.z = cvt_pk_bf16(v1[0], v1[1]); w.w = cvt_pk_bf16(v1[2], v1[3]);
                        *(u32x4*)(rowp + bj * HALF) = w; } }
        }
    }
};
struct EpiResF32 {
    static constexpr bool PERM = false, AFTER_DRAIN = false;
    const float* base; float* out; int ldc; float alpha;
    const float* pstat; const float* pg; const float* pb;
    __device__ __forceinline__ void operator()(const f32x4 (&acc)[2][2][4][2], const Unit& u, int wr, int wc, int fr, int fq) const {
        typedef f32x4 __attribute__((address_space(1))) gf4; typedef f32x2 __attribute__((address_space(1))) gf2;
        const float __attribute__((address_space(1)))* const bp = (const float __attribute__((address_space(1)))*)base;
        float __attribute__((address_space(1)))* const op = (float __attribute__((address_space(1)))*)out;
        const float __attribute__((address_space(1)))* const sp = (const float __attribute__((address_space(1)))*)pstat;
        const float __attribute__((address_space(1)))* const gp = (const float __attribute__((address_space(1)))*)pg;
        const float __attribute__((address_space(1)))* const bbp = (const float __attribute__((address_space(1)))*)pb;
        const int row0 = u.pm * BM + wr * 64 + fr, col0 = u.pn * BM + wc * 32 + 4 * fq;
        f32x2 st[2][4];
        if (sp) {
#pragma unroll
            for (int ai = 0; ai < 2; ++ai)
#pragma unroll
                for (int m = 0; m < 4; ++m) st[ai][m] = *(const gf2*)(sp + (unsigned)(2 * (row0 + ai * HALF + m * 16)));
        }
#pragma unroll
        for (int bj = 0; bj < 2; ++bj)
#pragma unroll
            for (int n = 0; n < 2; ++n) {
                const int cc = col0 + bj * HALF + n * 16;
                f32x4 gv, bv; if (sp) { gv = *(const gf4*)(gp + cc); bv = *(const gf4*)(bbp + cc); }
                f32x4 bs[2][4];
#pragma unroll
                for (int ai = 0; ai < 2; ++ai)
#pragma unroll
                    for (int m = 0; m < 4; ++m) bs[ai][m] = *(const gf4*)(bp + (unsigned)((row0 + ai * HALF + m * 16) * ldc + cc));
#pragma unroll
                for (int ai = 0; ai < 2; ++ai)
#pragma unroll
                    for (int m = 0; m < 4; ++m) { f32x4 x = bs[ai][m];
                        if (sp) x = (x - st[ai][m].x) * st[ai][m].y * gv + bv;
                        *(gf4*)(op + (unsigned)((row0 + ai * HALF + m * 16) * ldc + cc)) = x * alpha + acc[ai][bj][m][n]; }
                asm volatile("" ::: "memory"); }
    }
};
struct EpiMix {
    static constexpr bool PERM = true, AFTER_DRAIN = false;
    const bf16_t* CV; bf16_t* Y; const float* cw;
    static __device__ __forceinline__ void up8(const u32x4 w, f32x4& lo, f32x4& hi) {
        lo = (f32x4){__uint_as_float(w.x << 16), __uint_as_float(w.x & 0xffff0000u), __uint_as_float(w.y << 16), __uint_as_float(w.y & 0xffff0000u)};
        hi = (f32x4){__uint_as_float(w.z << 16), __uint_as_float(w.z & 0xffff0000u), __uint_as_float(w.w << 16), __uint_as_float(w.w & 0xffff0000u)}; }
    __device__ __forceinline__ void operator()(const f32x4 (&acc)[2][2][4][2], const Unit& u, int wr, int wc, int fr, int fq) const {
        typedef u32x4 __attribute__((address_space(1))) gu4; typedef f32x4 __attribute__((address_space(1))) gf4;
        const bf16_t __attribute__((address_space(1)))* const cvp = (const bf16_t __attribute__((address_space(1)))*)CV;
        bf16_t __attribute__((address_space(1)))* const yp = (bf16_t __attribute__((address_space(1)))*)Y;
        const float __attribute__((address_space(1)))* const wp = (const float __attribute__((address_space(1)))*)cw;
        const int row0 = u.pm * BM + wr * 64 + fr;
#pragma unroll
        for (int bj = 0; bj < 2; ++bj) {
            const int ch = u.pn * BM + bj * HALF + wc * 32 + 8 * fq;
            const f32x4 w0a = *(const gf4*)(wp + ch), w0b = *(const gf4*)(wp + ch + 4), w1a = *(const gf4*)(wp + 2048 + ch), w1b = *(const gf4*)(wp + 2048 + ch + 4),
                        w2a = *(const gf4*)(wp + 4096 + ch), w2b = *(const gf4*)(wp + 4096 + ch + 4);
#pragma unroll
            for (int ai = 0; ai < 2; ++ai) {
                u32x4 c0[4], c1[4], c2[4];
#pragma unroll
                for (int m = 0; m < 4; ++m) { const int t = row0 + ai * HALF + m * 16; const unsigned off = (unsigned)(t * 2048 + ch);
                    c0[m] = *(const gu4*)(cvp + off);
                    c1[m] = (t & 4095) >= 1 ? *(const gu4*)(cvp + off - 2048) : (u32x4){0u, 0u, 0u, 0u};
                    c2[m] = (t & 4095) >= 2 ? *(const gu4*)(cvp + off - 4096) : (u32x4){0u, 0u, 0u, 0u}; }
#pragma unroll
                for (int m = 0; m < 4; ++m) { const int t = row0 + ai * HALF + m * 16;
                    f32x4 a0, b0, a1, b1, a2, b2; up8(c0[m], a0, b0); up8(c1[m], a1, b1); up8(c2[m], a2, b2);
                    const f32x4 ya = acc[ai][bj][m][0] * (w0a * a2 + w1a * a1 + w2a * a0), yb = acc[ai][bj][m][1] * (w0b * b2 + w1b * b1 + w2b * b0);
                    u32x4 w; w.x = cvt_pk_bf16(ya[0], ya[1]); w.y = cvt_pk_bf16(ya[2], ya[3]); w.z = cvt_pk_bf16(yb[0], yb[1]); w.w = cvt_pk_bf16(yb[2], yb[3]);
                    *(gu4*)(yp + (unsigned)(t * 2048 + ch)) = w; }
            }
        }
    }
};
template <int CTRL> __device__ __forceinline__ float dpp_ror(float v) { return __builtin_bit_cast(float, __builtin_amdgcn_update_dpp(0, __builtin_bit_cast(int, v), CTRL, 0xF, 0xF, false)); }
struct EpiConvGate {
    static constexpr bool PERM = true, AFTER_DRAIN = false;
    bf16_t* ACT; bf16_t* HALO; const float* cw; const float* cb;
    __device__ __forceinline__ void operator()(const f32x4 (&acc)[2][2][4][2], const Unit& u, int wr, int wc, int fr, int fq) const {
        constexpr int FF_ = 5632, N2 = 2 * FF_;
        typedef f32x4 __attribute__((address_space(1))) gf4; typedef u32x2 __attribute__((address_space(1))) gu2;
        const float __attribute__((address_space(1)))* const cwp = (const float __attribute__((address_space(1)))*)cw;
        const float __attribute__((address_space(1)))* const cbp = (const float __attribute__((address_space(1)))*)cb;
        bf16_t __attribute__((address_space(1)))* const actp = (bf16_t __attribute__((address_space(1)))*)ACT;
        bf16_t __attribute__((address_space(1)))* const halop = (bf16_t __attribute__((address_space(1)))*)HALO;
        const int chl = wc * 32 + 8 * fq;
        f32x4 wgv[2][3], wuv[2][3], bgv[2], buv[2];
#pragma unroll
        for (int n = 0; n < 2; ++n) { const unsigned ch = (unsigned)(u.pn * 128 + chl + 4 * n);
#pragma unroll
            for (int q = 0; q < 3; ++q) { wgv[n][q] = *(const gf4*)(cwp + q * N2 + ch); wuv[n][q] = *(const gf4*)(cwp + q * N2 + FF_ + ch); }
            bgv[n] = *(const gf4*)(cbp + ch); buv[n] = *(const gf4*)(cbp + FF_ + ch); }
#pragma unroll
        for (int n = 0; n < 2; ++n) {
            const int ch = u.pn * 128 + chl + 4 * n;
            const f32x4 wg0 = wgv[n][0], wg1 = wgv[n][1], wg2 = wgv[n][2], bg = bgv[n], wu0 = wuv[n][0], wu1 = wuv[n][1], wu2 = wuv[n][2], bu = buv[n];
#pragma unroll
            for (int ai = 0; ai < 2; ++ai) {
                const int rb = u.pm * BM + ai * HALF + wr * 64;
                f32x4 pg1 = {0.f, 0.f, 0.f, 0.f}, pg2 = pg1, pu1 = pg1, pu2 = pg1;
#pragma unroll
                for (int m = 0; m < 4; ++m) {
                    const f32x4 g = acc[ai][0][m][n], uu = acc[ai][1][m][n];
                    f32x4 rg1, rg2, ru1, ru2;
#pragma unroll
                    for (int j = 0; j < 4; ++j) { rg1[j] = dpp_ror<0x121>(g[j]); rg2[j] = dpp_ror<0x122>(g[j]); ru1[j] = dpp_ror<0x121>(uu[j]); ru2[j] = dpp_ror<0x122>(uu[j]); }
                    const f32x4 hg1 = fr >= 1 ? rg1 : pg1, hg2 = fr >= 2 ? rg2 : pg2, hu1 = fr >= 1 ? ru1 : pu1, hu2 = fr >= 2 ? ru2 : pu2;
                    const f32x4 gc = wg0 * hg2 + wg1 * hg1 + wg2 * g + bg, uc = wu0 * hu2 + wu1 * hu1 + wu2 * uu + bu;
                    f32x4 a;
#pragma unroll
                    for (int j = 0; j < 4; ++j) a[j] = gc[j] * __builtin_amdgcn_rcpf(1.0f + __builtin_amdgcn_exp2f(-1.4426950408889634f * gc[j])) * uc[j];
                    if (m > 0 || fr >= 2) { u32x2 w; w.x = cvt_pk_bf16(a[0], a[1]); w.y = cvt_pk_bf16(a[2], a[3]);
                        *(gu2*)(actp + (unsigned)((rb + m * 16 + fr) * FF_ + ch)) = w; }
                    if (m == 0 && fr < 2) { bf16_t __attribute__((address_space(1)))* hp = halop + (unsigned)(((rb >> 6) * 4 + 2 + fr) * N2 + u.pn * 256 + chl + 4 * n);
                        u32x2 hg, hu; hg.x = cvt_pk_bf16(g[0], g[1]); hg.y = cvt_pk_bf16(g[2], g[3]); hu.x = cvt_pk_bf16(uu[0], uu[1]); hu.y = cvt_pk_bf16(uu[2], uu[3]); *(gu2*)hp = hg; *(gu2*)(hp + 128) = hu; }
                    if (m == 3 && fr >= 14) { bf16_t __attribute__((address_space(1)))* hp = halop + (unsigned)(((rb >> 6) * 4 + (fr - 14)) * N2 + u.pn * 256 + chl + 4 * n);
                        u32x2 hg, hu; hg.x = cvt_pk_bf16(g[0], g[1]); hg.y = cvt_pk_bf16(g[2], g[3]); hu.x = cvt_pk_bf16(uu[0], uu[1]); hu.y = cvt_pk_bf16(uu[2], uu[3]); *(gu2*)hp = hg; *(gu2*)(hp + 128) = hu; }
                    pg1 = rg1; pg2 = rg2; pu1 = ru1; pu2 = ru2;
                }
            }
        }
    }
};
template <class Epi, class Sched, bool ALIGN_EPI = false, bool SP2 = false>
__device__ __forceinline__ void gemm_phase(PG8_LAS unsigned char* lds, const Gemm g, const Sched& S, const Epi& E) {
    const int tid = otid(), wid = __builtin_amdgcn_readfirstlane(tid >> 6), lane = tid & 63, wr = wid >> 2, wc = wid & 3, fr = lane & 15, fq = lane >> 4;
    const int K = g.K, nt = K / BK;
    unsigned voffA[2], voffB[2];
#pragma unroll
    for (int i = 0; i < 2; ++i) { int R, C; stage_rc(tid * 16 + i * 8192, R, C); const int Rb = Epi::PERM ? ((R & ~31) + perm32(R & 31)) : R;
        voffA[i] = (unsigned)(R * K + C) * 2u; voffB[i] = (unsigned)(Rb * K + C) * 2u; }
    const size_t kstep = (size_t)(BK * 2);
    const size_t hstep = (size_t)HALF * K * 2;
    const size_t tstep = 2 * hstep;
    const unsigned ldsw = (unsigned)wid * 1024u;
    const int aoff = lds_byte(wr * 64 + fr, fq * 8), boff = lds_byte(wc * 32 + fr, fq * 8);
#define PG8_SA(b, h) (((b) * 2 + (h)) * HTB)
#define PG8_SB(b, h) ((4 + (b) * 2 + (h)) * HTB)
#define PG8_STAGE(bufoff, gbase, voff) do { _Pragma("unroll") for (int _i = 0; _i < 2; ++_i) \
        __builtin_amdgcn_global_load_lds((const unsigned*)((const char*)(gbase) + (voff)[_i]), (PG8_LAS unsigned*)(lds + (bufoff) + ldsw + _i * 8192), 16, 0, 0); } while (0)
#define PG8_LDA(dst, b, h) do { _Pragma("unroll") for (int m = 0; m < 4; ++m) _Pragma("unroll") for (int k = 0; k < 2; ++k) dst[m][k] = *(const PG8_LAS bf16x8*)(lds + PG8_SA(b, h) + aoff + m * 2048 + k * 1024); } while (0)
#define PG8_LDB(dst, b, h) do { _Pragma("unroll") for (int n = 0; n < 2; ++n) _Pragma("unroll") for (int k = 0; k < 2; ++k) dst[n][k] = *(const PG8_LAS bf16x8*)(lds + PG8_SB(b, h) + boff + n * 2048 + k * 1024); } while (0)
#define PG8_MMA(ai, bj, At, Bt) do { __builtin_amdgcn_s_setprio(1); _Pragma("unroll") for (int m = 0; m < 4; ++m) _Pragma("unroll") for (int n = 0; n < 2; ++n) _Pragma("unroll") for (int k = 0; k < 2; ++k) \
        acc[ai][bj][m][n] = __builtin_amdgcn_mfma_f32_16x16x32_bf16(Bt[n][k], At[m][k], acc[ai][bj][m][n], 0, 0, 0); __builtin_amdgcn_s_setprio(0); } while (0)
#define PG8_WAIT_V(n) asm volatile("s_waitcnt vmcnt(" #n ")" ::: "memory")
#define PG8_WAIT_L(n) asm volatile("s_waitcnt lgkmcnt(" #n ")" ::: "memory")
#define PG8_BAR __builtin_amdgcn_s_barrier()
#define PG8_SCHED __builtin_amdgcn_sched_barrier(0)
    Unit cur, nxt; int ui = 0;
    if (!S.next(0, cur)) return;
    f32x4 acc[2][2][4][2];
#pragma unroll
    for (int a = 0; a < 2; ++a)
#pragma unroll
        for (int b = 0; b < 2; ++b)
#pragma unroll
            for (int m = 0; m < 4; ++m)
#pragma unroll
                for (int n = 0; n < 2; ++n) acc[a][b][m][n] = (f32x4){0.f, 0.f, 0.f, 0.f};
    bf16x8 At[4][2], B0[2][2], B1[2][2];
    const char* cA = (const char*)g.A + (size_t)cur.pm * tstep; const char* cB = (const char*)g.Bt + (size_t)cur.pn * tstep;
    S.a_ready(cur);
    if constexpr (SP2) {
        PG8_STAGE(PG8_SB(0, 0), cB, voffB); PG8_STAGE(PG8_SB(0, 1), cB + hstep, voffB); PG8_STAGE(PG8_SA(0, 0), cA, voffA); PG8_STAGE(PG8_SA(0, 1), cA + hstep, voffA);
        if (wr == 1) PG8_BAR;
        PG8_WAIT_V(2); PG8_BAR;
        PG8_STAGE(PG8_SB(1, 0), cB + kstep, voffB); PG8_STAGE(PG8_SA(1, 0), cA + kstep, voffA); PG8_STAGE(PG8_SB(1, 1), cB + hstep + kstep, voffB);
        PG8_WAIT_V(6); PG8_BAR;
    } else {
        PG8_STAGE(PG8_SB(0, 0), cB, voffB); PG8_STAGE(PG8_SA(0, 0), cA, voffA); PG8_STAGE(PG8_SB(0, 1), cB + hstep, voffB); PG8_STAGE(PG8_SA(0, 1), cA + hstep, voffA);
        if (wr == 1) PG8_BAR;
        PG8_WAIT_V(4); PG8_BAR;
        PG8_STAGE(PG8_SB(1, 0), cB + kstep, voffB); PG8_STAGE(PG8_SA(1, 0), cA + kstep, voffA); PG8_STAGE(PG8_SB(1, 1), cB + hstep + kstep, voffB);
        PG8_WAIT_V(6); PG8_BAR;
    }
    for (;;) {
        const bool has_next = S.next(ui + 1, nxt);
        const char* nA = has_next ? (const char*)g.A + (size_t)nxt.pm * tstep : cA; const char* nB = has_next ? (const char*)g.Bt + (size_t)nxt.pn * tstep : cB;
        for (int t = 0; t < nt; t += 2) {
            const bool last = (t == nt - 2);
            const char* a1 = cA + (size_t)(t + 1) * kstep;
            const char* a2 = last ? nA : cA + (size_t)(t + 2) * kstep; const char* b2 = last ? nB : cB + (size_t)(t + 2) * kstep;
            const char* a3 = a2 + kstep; const char* b3 = b2 + kstep;
            if (last && has_next) S.a_ready(nxt);
            if constexpr (SP2) {
            PG8_LDB(B0, 0, 0); PG8_LDB(B1, 0, 1); PG8_SCHED; PG8_LDA(At, 0, 0); PG8_STAGE(PG8_SA(1, 1), a1 + hstep, voffA);
            PG8_WAIT_V(8); PG8_WAIT_L(0); PG8_BAR; PG8_MMA(0, 0, At, B0); PG8_MMA(0, 1, At, B1); PG8_BAR; PG8_SCHED;
            PG8_LDA(At, 0, 1); PG8_STAGE(PG8_SB(0, 0), b2, voffB); PG8_STAGE(PG8_SB(0, 1), b2 + hstep, voffB); PG8_STAGE(PG8_SA(0, 0), a2, voffA);
            PG8_WAIT_V(8); PG8_WAIT_L(0); PG8_BAR; PG8_MMA(1, 0, At, B0); PG8_MMA(1, 1, At, B1); PG8_BAR; PG8_SCHED;
            PG8_LDB(B0, 1, 0); PG8_LDB(B1, 1, 1); PG8_SCHED; PG8_LDA(At, 1, 0); PG8_STAGE(PG8_SA(0, 1), a2 + hstep, voffA);
            PG8_WAIT_V(8); PG8_WAIT_L(0); PG8_BAR; PG8_MMA(0, 0, At, B0); PG8_MMA(0, 1, At, B1); PG8_BAR; PG8_SCHED;
            PG8_LDA(At, 1, 1); PG8_STAGE(PG8_SB(1, 0), b3, voffB); PG8_STAGE(PG8_SB(1, 1), b3 + hstep, voffB); PG8_STAGE(PG8_SA(1, 0), a3, voffA);
            PG8_WAIT_V(8); PG8_WAIT_L(0); PG8_BAR; PG8_MMA(1, 0, At, B0); PG8_MMA(1, 1, At, B1); PG8_BAR; PG8_SCHED;
            } else {
            PG8_LDB(B0, 0, 0); PG8_SCHED; PG8_LDA(At, 0, 0); PG8_STAGE(PG8_SA(1, 1), a1 + hstep, voffA);
            PG8_WAIT_L(8); PG8_BAR; PG8_WAIT_L(0); PG8_MMA(0, 0, At, B0); PG8_BAR; PG8_SCHED;
            PG8_LDB(B1, 0, 1); PG8_STAGE(PG8_SB(0, 0), b2, voffB);
            PG8_BAR; PG8_WAIT_L(0); PG8_MMA(0, 1, At, B1); PG8_BAR;
            PG8_LDA(At, 0, 1); PG8_STAGE(PG8_SA(0, 0), a2, voffA);
            PG8_BAR; PG8_WAIT_L(0); PG8_MMA(1, 0, At, B0); PG8_BAR; PG8_SCHED;
            PG8_STAGE(PG8_SB(0, 1), b2 + hstep, voffB);
            PG8_WAIT_V(6); PG8_BAR; PG8_MMA(1, 1, At, B1); PG8_BAR;
            PG8_LDB(B0, 1, 0); PG8_SCHED; PG8_LDA(At, 1, 0); PG8_STAGE(PG8_SA(0, 1), a2 + hstep, voffA);
            PG8_WAIT_L(8); PG8_BAR; PG8_WAIT_L(0); PG8_MMA(0, 0, At, B0); PG8_BAR; PG8_SCHED;
            PG8_LDB(B1, 1, 1); PG8_STAGE(PG8_SB(1, 0), b3, voffB);
            PG8_BAR; PG8_WAIT_L(0); PG8_MMA(0, 1, At, B1); PG8_BAR;
            PG8_LDA(At, 1, 1); PG8_STAGE(PG8_SA(1, 0), a3, voffA);
            PG8_BAR; PG8_WAIT_L(0); PG8_MMA(1, 0, At, B0); PG8_BAR; PG8_SCHED;
            PG8_STAGE(PG8_SB(1, 1), b3 + hstep, voffB);
            PG8_WAIT_V(6); PG8_BAR; PG8_MMA(1, 1, At, B1); PG8_BAR;
            }
        }
        if constexpr (ALIGN_EPI) { if (wr == 0) PG8_BAR; }
        if constexpr (!Epi::AFTER_DRAIN) { E(acc, cur, wr, wc, fr, fq); S.done(cur); }
        if (!has_next) break;
#pragma unroll
        for (int a = 0; a < 2; ++a)
#pragma unroll
            for (int b = 0; b < 2; ++b)
#pragma unroll
                for (int m = 0; m < 4; ++m)
#pragma unroll
                    for (int n = 0; n < 2; ++n) acc[a][b][m][n] = (f32x4){0.f, 0.f, 0.f, 0.f};
        cur = nxt; cA = nA; cB = nB; ++ui;
        if constexpr (ALIGN_EPI) { if (wr == 1) PG8_BAR; }
    }
    PG8_WAIT_V(0);
    if constexpr (!ALIGN_EPI) { if (wr == 0) PG8_BAR; }
    PG8_BAR;
    if constexpr (Epi::AFTER_DRAIN) { E.fused(acc, cur, wr, wc, fr, fq, lds, wid, lane); S.done(cur); }
#undef PG8_SA
#undef PG8_SB
#undef PG8_STAGE
#undef PG8_LDA
#undef PG8_LDB
#undef PG8_MMA
#undef PG8_WAIT_V
#undef PG8_WAIT_L
#undef PG8_BAR
#undef PG8_SCHED
}
}

namespace att {
constexpr int D = 128;
constexpr float THR = 8.f;
constexpr bool WSKIP = false;
constexpr int LDQ = 6144, LDKV = 6144, LDO = 2048;
constexpr float SCALE = 0.08838834764831845f;
constexpr int NW = 8, QBLK = 32, KVBLK = 64, QB = NW * QBLK;
constexpr int SHM_V = KVBLK * D * 2, SHM_K = KVBLK * D * 2;
constexpr int LDS_BYTES = 2 * SHM_V + 2 * SHM_K + NW * 64 * 4;

using bf16 = __hip_bfloat16;
typedef short bf16x8 __attribute__((ext_vector_type(8)));
typedef short s16x4 __attribute__((ext_vector_type(4)));
typedef float f32x16 __attribute__((ext_vector_type(16)));
typedef float f32x4 __attribute__((ext_vector_type(4)));
typedef unsigned u32x4 __attribute__((ext_vector_type(4)));
template <class A, class Bt> struct same_t { static constexpr bool v = false; };
template <class A> struct same_t<A, A> { static constexpr bool v = true; };

#define KSWZ(row, colB) ((row) * 256 + ((colB) ^ (((row) & 7) << 4)))
#define SBAR() __builtin_amdgcn_sched_barrier(0)
__device__ __forceinline__ int v_st(int k, int c) { const int kk = (k & ~0xC) | ((k & 4) << 1) | ((k & 8) >> 1); return ((kk >> 3) * 4 + (c >> 5)) * 512 + ((kk & 7) * 32 + (c & 31)) * 2; }
__device__ __forceinline__ int v_rd_base(int lane) { return ((lane & 3) << 3) | (((lane >> 2) & 3) << 6) | (((lane >> 4) & 1) << 5) | (((lane >> 5) & 1) << 8); }
constexpr int v_rd_off(int d0, int ks, int half) { return d0 * 512 + ks * 4096 + half * 2048; }
__device__ __forceinline__ int crow(int r, int hi) { return (r & 3) + 8 * (r >> 2) + 4 * hi; }
__device__ __forceinline__ unsigned cvtpk(float lo, float hi) {
    unsigned r; asm volatile("v_cvt_pk_bf16_f32 %0, %1, %2" : "=v"(r) : "v"(lo), "v"(hi)); return r;
}
__device__ __forceinline__ bf16x8 pack8(f32x4 a, f32x4 b) {
    u32x4 w = {cvtpk(a[0], a[1]), cvtpk(a[2], a[3]), cvtpk(b[0], b[1]), cvtpk(b[2], b[3])};
    return *reinterpret_cast<bf16x8*>(&w);
}
template <class T> __device__ __forceinline__ bf16x8 load8(const T* p) {
    if constexpr (same_t<T, float>::v) { return pack8(*(const f32x4*)p, *(const f32x4*)(p + 4)); }
    else { return *reinterpret_cast<const bf16x8*>(p); }
}
__device__ __forceinline__ void mask_tile(f32x16& p0, f32x16& p1, int dq, unsigned W) {
    const float NEG = -__builtin_inff();
#pragma unroll
    for (int r = 0; r < 16; ++r) {
        const int c = (r & 3) + 8 * (r >> 2);
        if ((unsigned)(dq - c) >= W) p0[r] = NEG;
        if ((unsigned)(dq - c - 32) >= W) p1[r] = NEG;
    }
}
__device__ __forceinline__ void partialSM(f32x16& p0, f32x16& p1, float& m_reg, float& mn, float& alpha) {
    float pmax = p0[0]; for (int r = 1; r < 16; ++r) pmax = fmaxf(pmax, p0[r]); for (int r = 0; r < 16; ++r) pmax = fmaxf(pmax, p1[r]);
    { auto rr = __builtin_amdgcn_permlane32_swap(__float_as_uint(pmax), __float_as_uint(pmax), false, false);
      pmax = fmaxf(__uint_as_float(rr[0]), __uint_as_float(rr[1])); }
    constexpr float C2 = 1.4426950408889634f * SCALE;
    if (__builtin_expect(__all((pmax - m_reg) * SCALE <= THR), 1)) { mn = m_reg; alpha = 1.f; }
    else { mn = fmaxf(m_reg, pmax); alpha = __builtin_amdgcn_exp2f((m_reg - mn) * C2); m_reg = mn; }
    const float mnL = -mn * C2;
    for (int r = 0; r < 16; ++r) p0[r] = fmaf(p0[r], C2, mnL); for (int r = 0; r < 16; ++r) p1[r] = fmaf(p1[r], C2, mnL);
    for (int r = 0; r < 16; ++r) p0[r] = __builtin_amdgcn_exp2f(p0[r]);
}
__device__ __forceinline__ void finishSM(f32x16& p0, f32x16& p1, float alpha, float& l_reg, bf16x8& pa0, bf16x8& pa1, bf16x8& pa2, bf16x8& pa3) {
    for (int r = 0; r < 16; ++r) p1[r] = __builtin_amdgcn_exp2f(p1[r]);
    float ps = 0; for (int r = 0; r < 16; ++r) ps += p0[r]; for (int r = 0; r < 16; ++r) ps += p1[r];
    { auto rr = __builtin_amdgcn_permlane32_swap(__float_as_uint(ps), __float_as_uint(ps), false, false);
      ps = __uint_as_float(rr[0]) + __uint_as_float(rr[1]); }
    l_reg = l_reg * alpha + ps;
#define PK4(P, B_, OUT) do { unsigned a0 = cvtpk(P[B_+0], P[B_+1]), a1 = cvtpk(P[B_+2], P[B_+3]);                          \
        unsigned b0 = cvtpk(P[B_+4], P[B_+5]), b1 = cvtpk(P[B_+6], P[B_+7]);                                             \
        auto r0 = __builtin_amdgcn_permlane32_swap(a0, b0, false, false); auto r1 = __builtin_amdgcn_permlane32_swap(a1, b1, false, false); \
        u32x4 w = {r0[0], r1[0], r0[1], r1[1]}; OUT = *reinterpret_cast<bf16x8*>(&w); } while (0)
    PK4(p0, 0, pa0); PK4(p0, 8, pa1); PK4(p1, 0, pa2); PK4(p1, 8, pa3);
#undef PK4
}
template <int KB, bool SK>
__device__ __forceinline__ void qkt(f32x16& p0, f32x16& p1, const char* K_lds, int r32, int hi, const bf16x8* qr, bool act) {
    if (SK && !act) { const float NEG = -__builtin_inff();
#pragma unroll
        for (int r = 0; r < 16; ++r) { p0[r] = NEG; p1[r] = NEG; } return; }
    p0 = f32x16{}; p1 = f32x16{};
    const char* kb[4];
#pragma unroll
    for (int dd = 0; dd < 4; ++dd) kb[dd] = K_lds + KB * SHM_K + KSWZ(r32, (dd * 16 + hi * 8) * 2);
#pragma unroll
    for (int d0 = 0; d0 < 8; ++d0) { const char* a = kb[d0 & 3] + (d0 >> 2) * 128;
        bf16x8 b0 = *reinterpret_cast<const bf16x8*>(a);
        bf16x8 b1 = *reinterpret_cast<const bf16x8*>(a + 32 * 256);
        p0 = __builtin_amdgcn_mfma_f32_32x32x16_bf16(b0, qr[d0], p0, 0, 0, 0);
        p1 = __builtin_amdgcn_mfma_f32_32x32x16_bf16(b1, qr[d0], p1, 0, 0, 0); }
}
template <int VB, bool SK>
__device__ __forceinline__ void pv_tile(f32x16* o, int vb0, bf16x8 pa0, bf16x8 pa1, bf16x8 pa2, bf16x8 pa3, bool act) {
    if (SK && !act) return;
#define TRRD(dst, off) asm volatile("ds_read_b64_tr_b16 %0, %1 offset:%2" : "=&v"(dst) : "v"(vb0), "i"(off) : "memory")
#define PV_D0(d0) do { s16x4 l0, l1, l2, l3, h0, h1, h2, h3; constexpr int b_ = VB * SHM_V + v_rd_off(d0, 0, 0);     \
        TRRD(l0, b_); TRRD(h0, b_ + 2048); TRRD(l1, b_ + 4096); TRRD(h1, b_ + 6144); TRRD(l2, b_ + 8192); TRRD(h2, b_ + 10240); TRRD(l3, b_ + 12288); TRRD(h3, b_ + 14336); \
        asm volatile("s_waitcnt lgkmcnt(0)" ::: "memory"); SBAR();                 \
        o[d0] = __builtin_amdgcn_mfma_f32_32x32x16_bf16(pa0, (bf16x8){l0[0], l0[1], l0[2], l0[3], h0[0], h0[1], h0[2], h0[3]}, o[d0], 0, 0, 0);   \
        o[d0] = __builtin_amdgcn_mfma_f32_32x32x16_bf16(pa1, (bf16x8){l1[0], l1[1], l1[2], l1[3], h1[0], h1[1], h1[2], h1[3]}, o[d0], 0, 0, 0);   \
        o[d0] = __builtin_amdgcn_mfma_f32_32x32x16_bf16(pa2, (bf16x8){l2[0], l2[1], l2[2], l2[3], h2[0], h2[1], h2[2], h2[3]}, o[d0], 0, 0, 0);   \
        o[d0] = __builtin_amdgcn_mfma_f32_32x32x16_bf16(pa3, (bf16x8){l3[0], l3[1], l3[2], l3[3], h3[0], h3[1], h3[2], h3[3]}, o[d0], 0, 0, 0); } while (0)
    PV_D0(0); PV_D0(1); PV_D0(2); PV_D0(3);
#undef PV_D0
#undef TRRD
}

template <class TIn, class TOut> struct BlockRef { const TIn* Q; const TIn* K; const TIn* V; TOut* O; int P0; };
template <class TIn> struct Seam {
    bf16x8 qr[8];
    bf16x8 st_v0, st_v1, st_k0, st_k1; f32x4 sf0, sf1, sf2, sf3;
    f32x4 tq[16];
};
__device__ __forceinline__ int swa_jlo(int P0, int W) { const int lowk = P0 - W + 1; return lowk > 0 ? lowk / KVBLK : 0; }
#define ROW(p, k0, rr) ((p) + (size_t)((k0) + (rr)) * LDKV + sc)
#define VMW() asm volatile("s_waitcnt vmcnt(0)" ::: "memory")
#define VMWN(n) asm volatile("s_waitcnt vmcnt(%0)" :: "i"(n) : "memory")
#define SLOAD_H(Kp, Vp, k0) do { S.st_v0 = load8<TIn>(ROW(Vp, k0, sr)); S.st_v1 = load8<TIn>(ROW(Vp, k0, 32 + sr));              \
                         S.st_k0 = load8<TIn>(ROW(Kp, k0, sr)); S.st_k1 = load8<TIn>(ROW(Kp, k0, 32 + sr)); } while (0)
#define SWRITE_HK(bf) do { *(bf16x8*)(K_lds + (bf) * SHM_K + kws) = S.st_k0; *(bf16x8*)(K_lds + (bf) * SHM_K + kws + 32 * 256) = S.st_k1; } while (0)
#define SWRITE_HV(bf) do { *(bf16x8*)(V_lds + (bf) * SHM_V + vst0) = S.st_v0; *(bf16x8*)(V_lds + (bf) * SHM_V + vst1) = S.st_v1; } while (0)
#define SWRITE_H(bf) do { SWRITE_HV(bf); SWRITE_HK(bf); } while (0)
#define SLOAD_F(p, k0) do { S.sf0 = *(const f32x4*)ROW(p, k0, sr); S.sf1 = *(const f32x4*)(ROW(p, k0, sr) + 4);                \
                            S.sf2 = *(const f32x4*)ROW(p, k0, 32 + sr); S.sf3 = *(const f32x4*)(ROW(p, k0, 32 + sr) + 4); } while (0)
#define SWRITE_KF(bf) do { *(bf16x8*)(K_lds + (bf) * SHM_K + kws) = pack8(S.sf0, S.sf1); *(bf16x8*)(K_lds + (bf) * SHM_K + kws + 32 * 256) = pack8(S.sf2, S.sf3); } while (0)
#define SWRITE_VF(bf) do { *(bf16x8*)(V_lds + (bf) * SHM_V + vst0) = pack8(S.sf0, S.sf1); *(bf16x8*)(V_lds + (bf) * SHM_V + vst1) = pack8(S.sf2, S.sf3); } while (0)
template <class TIn, class TOut>
__device__ __forceinline__ void causal_swa_prime(const BlockRef<TIn, TOut>& cur, int W, char* lds, Seam<TIn>& S) {
    constexpr bool F32 = same_t<TIn, float>::v;
    const int tid = otid(), wid = __builtin_amdgcn_readfirstlane(tid >> 6), lane = tid & 63, r32 = lane & 31, hi = lane >> 5;
    const int sr = tid >> 4, sc = (tid & 15) * 8, kws = KSWZ(sr, sc * 2); char* K_lds = lds + 2 * SHM_V;
    const int kb0 = swa_jlo(cur.P0, W) * KVBLK;
    for (int d0 = 0; d0 < 8; ++d0) S.qr[d0] = load8<TIn>(cur.Q + (size_t)(wid * QBLK + r32) * LDQ + d0 * 16 + hi * 8);
    if constexpr (F32) { SLOAD_F((const float*)cur.K, kb0); VMW(); SWRITE_KF(0); SBAR(); SLOAD_F((const float*)cur.V, kb0); }
    else { SLOAD_H(cur.K, cur.V, kb0); VMW(); SWRITE_HK(0); }
    __syncthreads();
}
template <class TIn, class TOut>
__device__ __forceinline__ void causal_swa_block(const BlockRef<TIn, TOut>& cur, const BlockRef<TIn, TOut>& nxt, int skv, int W, char* lds, Seam<TIn>& S) {
    constexpr bool F32 = same_t<TIn, float>::v;
    const int tid = otid(), wid = __builtin_amdgcn_readfirstlane(tid >> 6), lane = tid & 63, r32 = lane & 31, hi = lane >> 5;
    const int j_lo = swa_jlo(cur.P0, W);
    int j_hi = (cur.P0 + QB - 1) / KVBLK + 1; if (j_hi > skv / KVBLK) j_hi = skv / KVBLK;
    const int NT = j_hi - j_lo;
    const int kbn = swa_jlo(nxt.P0, W) * KVBLK;
    const int qlo = cur.P0 + wid * QBLK, qm = qlo + r32 - 4 * hi;
    char* V_lds = lds; char* K_lds = lds + 2 * SHM_V;
    float* ws = (float*)(lds + 2 * SHM_V + 2 * SHM_K) + wid * 64; float* li_l = ws, * al_l = ws + 32;
    float m_reg = -1e30f, l_reg = 0; f32x16 o[4] = {};
    const int sr = tid >> 4, sc = (tid & 15) * 8, vst0 = v_st(sr, sc), vst1 = v_st(32 + sr, sc), kws = KSWZ(sr, sc * 2);
    const int vb0 = (int)(uintptr_t)V_lds + v_rd_base(lane);
    const TIn* Kh = cur.K; const TIn* Vh = cur.V;
#define RESC(a) do { if (__any((a) < 1.f)) { if (hi == 0) al_l[r32] = (a); asm volatile("s_waitcnt lgkmcnt(0)" ::: "memory");              \
                     for (int d_ = 0; d_ < 4; ++d_) for (int r = 0; r < 16; ++r) o[d_][r] *= al_l[crow(r, hi)]; } } while (0)
#define KBASE(t) ((j_lo + (t)) * KVBLK)
#define ACT(t) (KBASE(t) <= qlo + QBLK - 1 && KBASE(t) + KVBLK - 1 >= qlo - W + 1)
#define MASKT(P0_, P1_, t) do { const int kb_ = KBASE(t); if ((!SK || ACT(t)) && (kb_ + KVBLK - 1 > qlo || kb_ <= qlo + QBLK - 1 - W)) mask_tile(P0_, P1_, qm - kb_, (unsigned)W); } while (0)
    constexpr int NQL = F32 ? 16 : 8;
    constexpr bool SK = WSKIP && !F32;
#define SEAM_K0() do { VMWN(NQL); if constexpr (F32) { SWRITE_KF(0); SBAR(); SLOAD_F((const float*)nxt.V, kbn); } else { SWRITE_HK(0); } SBAR(); } while (0)
    f32x16 pA0, pA1, pB0, pB1; float mnA, mnB, alA, alB; bf16x8 pa0, pa1, pa2, pa3;
    if constexpr (F32) { VMW(); SWRITE_VF(0); SBAR(); } else { SWRITE_HV(0); SBAR(); }
    if (NT > 1) { if constexpr (F32) SLOAD_F((const float*)Kh, KBASE(1)); else SLOAD_H(Kh, Vh, KBASE(1)); }
    SBAR(); qkt<0, SK>(pA0, pA1, K_lds, r32, hi, S.qr, ACT(0));
    if constexpr (F32) { if (NT > 1) { VMW(); SWRITE_KF(1); SBAR(); SLOAD_F((const float*)Vh, KBASE(1)); } }
    MASKT(pA0, pA1, 0); partialSM(pA0, pA1, m_reg, mnA, alA);
    if (NT > 1) { VMW(); if constexpr (F32) { SWRITE_VF(1); SBAR(); if (NT > 2) SLOAD_F((const float*)Kh, KBASE(2)); } else SWRITE_H(1); }
    __syncthreads();
#define HALF_STEP(PX0, PX1, mnX, alX, PY0, PY1, alY, t, KB, VB, SB) do {                                                      \
        SBAR(); qkt<KB, SK>(PX0, PX1, K_lds, r32, hi, S.qr, ACT(t));                                             \
        finishSM(PY0, PY1, alY, l_reg, pa0, pa1, pa2, pa3); SBAR();                                                           \
        if ((t) + 1 < NT) { if constexpr (F32) { VMW(); SWRITE_KF(SB); SBAR(); SLOAD_F((const float*)Vh, KBASE((t) + 1)); }  \
                            else { SLOAD_H(Kh, Vh, KBASE((t) + 1)); } SBAR(); }                                               \
        pv_tile<VB, SK>(o, vb0, pa0, pa1, pa2, pa3, ACT((t) - 1)); MASKT(PX0, PX1, (t)); partialSM(PX0, PX1, m_reg, mnX, alX);                                        \
        __syncthreads();                                                                                                      \
        if ((t) + 1 < NT) { VMW(); if constexpr (F32) { SWRITE_VF(SB); SBAR(); if ((t) + 2 < NT) SLOAD_F((const float*)Kh, KBASE((t) + 2)); } \
                            else { SWRITE_H(SB); } }                                                                          \
        RESC(alX); __syncthreads(); } while (0)
    for (int t = 1; t + 1 < NT; t += 2) {
        HALF_STEP(pB0, pB1, mnB, alB, pA0, pA1, alA, t, 1, 0, 0);
        HALF_STEP(pA0, pA1, mnA, alA, pB0, pB1, alB, t + 1, 0, 1, 1);
    }
    const bool even = (NT & 1) == 0;
    if (even) { SBAR(); qkt<1, SK>(pB0, pB1, K_lds, r32, hi, S.qr, ACT(NT - 1)); SBAR(); }
#define QROW(e) (nxt.Q + (size_t)(wid * QBLK + r32) * LDQ + ((e) >> 1) * 16 + hi * 8 + ((e) & 1) * 4)
    if constexpr (F32) { SLOAD_F((const float*)nxt.K, kbn); SBAR();
#pragma unroll
        for (int e = 0; e < 8; ++e) S.tq[e] = *(const f32x4*)QROW(e); }
    else { SLOAD_H(nxt.K, nxt.V, kbn); SBAR();
#pragma unroll
        for (int d0 = 0; d0 < 8; ++d0) S.qr[d0] = load8<TIn>(nxt.Q + (size_t)(wid * QBLK + r32) * LDQ + d0 * 16 + hi * 8); }
    SBAR();
    finishSM(pA0, pA1, alA, l_reg, pa0, pa1, pa2, pa3); SBAR();
    if constexpr (F32) {
#pragma unroll
        for (int e = 8; e < 16; ++e) S.tq[e] = *(const f32x4*)QROW(e); SBAR(); }
#undef QROW
    pv_tile<0, SK>(o, vb0, pa0, pa1, pa2, pa3, ACT(even ? NT - 2 : NT - 1));
    if (even) { MASKT(pB0, pB1, NT - 1); partialSM(pB0, pB1, m_reg, mnB, alB); __syncthreads(); RESC(alB);
        finishSM(pB0, pB1, alB, l_reg, pa0, pa1, pa2, pa3); SBAR(); pv_tile<1, SK>(o, vb0, pa0, pa1, pa2, pa3, ACT(NT - 1)); }
    SBAR(); SEAM_K0();
    if (hi == 0) li_l[r32] = l_reg; asm volatile("s_waitcnt lgkmcnt(0)" ::: "memory");
    float rli[16];
#pragma unroll
    for (int r = 0; r < 16; ++r) rli[r] = __builtin_amdgcn_rcpf(li_l[crow(r, hi)]);
    TOut* Ow = cur.O + (size_t)(wid * QBLK) * LDO;
#pragma unroll
    for (int r = 0; r < 16; ++r) { const int orow = crow(r, hi);
#pragma unroll
        for (int d0 = 0; d0 < 4; ++d0) { const float v = o[d0][r] * rli[r];
            if constexpr (same_t<TOut, float>::v) { Ow[(size_t)orow * LDO + d0 * 32 + r32] = v; }
            else { const float vn = swz_xor<1>(v, lane);
                   if ((r32 & 1) == 0) *(unsigned*)(Ow + (size_t)orow * LDO + d0 * 32 + r32) = cvtpk(v, vn); } } }
    if constexpr (F32) {
#pragma unroll
        for (int d0 = 0; d0 < 8; ++d0) S.qr[d0] = pack8(S.tq[2 * d0], S.tq[2 * d0 + 1]); }
    __syncthreads();
#undef RESC
#undef KBASE
#undef ACT
#undef MASKT
#undef SEAM_K0
#undef HALF_STEP
}
#undef ROW
#undef VMW
#undef VMWN
#undef SLOAD_H
#undef SWRITE_HK
#undef SWRITE_HV
#undef SWRITE_H
#undef SLOAD_F
#undef SWRITE_KF
#undef SWRITE_VF

}

typedef unsigned short bf16_t;
typedef float f32x4 __attribute__((ext_vector_type(4)));
typedef unsigned u32x4 __attribute__((ext_vector_type(4)));
typedef unsigned u32x2 __attribute__((ext_vector_type(2)));
#define LAS __attribute__((address_space(3)))

constexpr int T_ = 16384, DM = 2048, FF = 5632, SEQ = 4096, N6 = 6144, NUP = 2 * FF;
constexpr float ALPHA = 1.4142135623730951f;
constexpr float LN_EPS = 1e-5f, SUBLN_EPS = 1e-5f;
constexpr float LAMBDA_INIT = 0.35550906759309685f;
constexpr int NTHREADS = 512, LDS_STAGE = 131072, LDS_BYTES = LDS_STAGE + 16 + 256;

constexpr size_t SZ_WIN = (size_t)N6 * DM * 2, SZ_WSQ = (size_t)DM * DM * 2, SZ_WUP = (size_t)NUP * DM * 2, SZ_WDN = (size_t)DM * FF * 2;
constexpr size_t OFF_WIN = 0, OFF_WOUT = OFF_WIN + SZ_WIN, OFF_WUP0 = OFF_WOUT + SZ_WSQ, OFF_WDN0 = OFF_WUP0 + SZ_WUP;
constexpr size_t OFF_WQKV = OFF_WDN0 + SZ_WDN, OFF_WO = OFF_WQKV + SZ_WIN, OFF_WUP1 = OFF_WO + SZ_WSQ, OFF_WDN1 = OFF_WUP1 + SZ_WUP;
constexpr size_t OFF_Z = OFF_WDN1 + SZ_WDN, OFF_XB = OFF_Z + (size_t)T_ * DM * 4, OFF_R = OFF_XB + (size_t)T_ * DM * 2;
constexpr size_t SZ_R = (size_t)T_ * 8192 * 2, OFF_ROPE = OFF_R + SZ_R, OFF_BAR = OFF_ROPE + (size_t)T_ * 16 * 4 * 2, OFF_LNST = OFF_BAR + 16384, WS_END = OFF_LNST + 3 * (size_t)T_ * 2 * 4;
#define LNST(i) ((float*)(ws + OFF_LNST) + (size_t)(i) * 2 * T_)
constexpr size_t R_BIG = 0, R_SMALL = (size_t)T_ * N6 * 2;
constexpr size_t R_ACT = 0, R_HALO = (size_t)T_ * FF * 2;
static_assert(R_HALO + (size_t)(T_ / 64) * 4 * NUP * 4 <= SZ_R, "halo fits");

struct Params {
    const float* x; const int* pos; const float* ln_g; const float* ln_b; const float* a_w_in; const float* a_conv_w; const float* a_w_out;
    const float* w_k; const float* w_v; const float* w_q; const float* lam; const float* subln_g; const float* w_o;
    const float* w_up; const float* ffn_cw; const float* ffn_cb; const float* w_dn;
    float* out; unsigned char* ws;
};

__device__ __forceinline__ unsigned pk2(float lo, float hi) { return pg8::cvt_pk_bf16(lo, hi); }
__device__ __forceinline__ float bf_lo(unsigned w) { return __uint_as_float(w << 16); }
__device__ __forceinline__ float bf_hi(unsigned w) { return __uint_as_float(w & 0xffff0000u); }
__device__ __forceinline__ float wave_sum(float v, int lane) {
    return wsum64(v, lane);
}
#define LDS_WAIT() asm volatile("s_waitcnt lgkmcnt(0)" ::: "memory")

struct TItem { const float* W; bf16_t* WT; int K, N, mode, row_off, item; };
__device__ __forceinline__ void titem_load(const TItem& t, int lane, f32x4 (&v)[8]) {
    const int nblk = t.N / 32, kb = t.item / nblk, nb = t.item - kb * nblk, k0 = 64 * kb, n0 = 32 * nb, c4 = (lane & 7) * 4;
#pragma unroll
    for (int i = 0; i < 8; ++i) v[i] = *(const f32x4*)(t.W + (size_t)(k0 + 8 * i + (lane >> 3)) * t.N + n0 + c4);
}
__device__ __forceinline__ void titem_store(const TItem& t, int lane, const f32x4 (&v)[8], LAS float* scr) {
    const int K = t.K, nblk = t.N / 32, kb = t.item / nblk, nb = t.item - kb * nblk, k0 = 64 * kb, n0 = 32 * nb, c4 = (lane & 7) * 4;
#pragma unroll
    for (int i = 0; i < 8; ++i) { const int kk = 8 * i + (lane >> 3);
        scr[kk * 33 + c4 + 0] = v[i][0]; scr[kk * 33 + c4 + 1] = v[i][1]; scr[kk * 33 + c4 + 2] = v[i][2]; scr[kk * 33 + c4 + 3] = v[i][3]; }
    LDS_WAIT();
    int drow0;
    if (t.mode == 0) drow0 = t.row_off + n0;
    else if (t.mode == 1) { const int isu = n0 >= FF, c = isu ? n0 - FF : n0; drow0 = (c >> 7) * 256 + (isu ? 128 : 0) + (c & 127); }
    else { if (n0 < DM) drow0 = 2 * DM + n0;
           else { const int isv = n0 >= 2 * DM, c = n0 - (isv ? 2 * DM : DM); drow0 = (c >> 7) * 256 + (isv ? 128 : 0) + (c & 127); } }
    const int c = lane & 7;
#pragma unroll
    for (int j = 0; j < 4; ++j) { const int n = (lane >> 3) + 8 * j; const LAS float* s = scr + (8 * c) * 33 + n;
        u32x4 o; o.x = pk2(s[0 * 33], s[1 * 33]); o.y = pk2(s[2 * 33], s[3 * 33]); o.z = pk2(s[4 * 33], s[5 * 33]); o.w = pk2(s[6 * 33], s[7 * 33]);
        *(u32x4*)(t.WT + (size_t)(drow0 + n) * K + k0 + 8 * c) = o; }
    LDS_WAIT();
}
__device__ __forceinline__ TItem titem_decode(const Params& p, unsigned char* ws, int it) {
    constexpr int I_IN = (DM / 64) * (N6 / 32), I_SQ = (DM / 64) * (DM / 32), I_UP = (DM / 64) * (NUP / 32), I_DN = (FF / 64) * (DM / 32);
    int r = it;
    if (r < I_IN) return TItem{p.a_w_in, (bf16_t*)(ws + OFF_WIN), DM, N6, 2, 0, r}; r -= I_IN;
    if (r < I_SQ) return TItem{p.a_w_out, (bf16_t*)(ws + OFF_WOUT), DM, DM, 0, 0, r}; r -= I_SQ;
    if (r < I_SQ) return TItem{p.w_q, (bf16_t*)(ws + OFF_WQKV), DM, DM, 0, 0, r}; r -= I_SQ;
    if (r < I_SQ) return TItem{p.w_k, (bf16_t*)(ws + OFF_WQKV), DM, DM, 0, DM, r}; r -= I_SQ;
    if (r < I_SQ) return TItem{p.w_v, (bf16_t*)(ws + OFF_WQKV), DM, DM, 0, 2 * DM, r}; r -= I_SQ;
    if (r < I_SQ) return TItem{p.w_o, (bf16_t*)(ws + OFF_WO), DM, DM, 0, 0, r}; r -= I_SQ;
    if (r < I_UP) return TItem{p.w_up, (bf16_t*)(ws + OFF_WUP0), DM, NUP, 1, 0, r}; r -= I_UP;
    if (r < I_UP) return TItem{p.w_up + (size_t)DM * NUP, (bf16_t*)(ws + OFF_WUP1), DM, NUP, 1, 0, r}; r -= I_UP;
    if (r < I_DN) return TItem{p.w_dn, (bf16_t*)(ws + OFF_WDN0), FF, DM, 0, 0, r}; r -= I_DN;
    return TItem{p.w_dn + (size_t)FF * DM, (bf16_t*)(ws + OFF_WDN1), FF, DM, 0, 0, r};
}
__device__ __forceinline__ void phase_prologue(const Params& p, LAS unsigned char* lds) {
    const int tid = otid(), lane = tid & 63, wave = tid >> 6;
    const int gw = blockIdx.x * 8 + wave, NGW = gridDim.x * 8;
    LAS float* scr = (LAS float*)(lds + wave * 16384);
    unsigned char* ws = p.ws;
    constexpr int NITEMS = (DM / 64) * (N6 / 32) + 5 * (DM / 64) * (DM / 32) + 2 * (DM / 64) * (NUP / 32) + 2 * (FF / 64) * (DM / 32);
    {
        int it = gw;
        f32x4 vc[8], vn[8];
        if (it < NITEMS) { const TItem t = titem_decode(p, ws, it); titem_load(t, lane, vc); }
        while (it < NITEMS) {
            const int itn = it + NGW;
            if (itn < NITEMS) { const TItem tn = titem_decode(p, ws, itn); titem_load(tn, lane, vn); }
            { const TItem t = titem_decode(p, ws, it); titem_store(t, lane, vc, scr); }
#pragma unroll
            for (int i = 0; i < 8; ++i) vc[i] = vn[i];
            it = itn;
        }
    }
    const int gt = blockIdx.x * NTHREADS + tid, NGT = gridDim.x * NTHREADS;
    bf16_t* XB = (bf16_t*)(ws + OFF_XB);
    for (int i = gt; i < T_ * DM / 8; i += 4 * NGT) {
        f32x4 a[4], b[4];
#pragma unroll
        for (int q = 0; q < 4; ++q) { const int ii = i + q * NGT; if (ii < T_ * DM / 8) { a[q] = *(const f32x4*)(p.x + (size_t)ii * 8); b[q] = *(const f32x4*)(p.x + (size_t)ii * 8 + 4); } }
#pragma unroll
        for (int q = 0; q < 4; ++q) { const int ii = i + q * NGT; if (ii < T_ * DM / 8) {
            u32x4 o; o.x = pk2(a[q][0], a[q][1]); o.y = pk2(a[q][2], a[q][3]); o.z = pk2(b[q][0], b[q][1]); o.w = pk2(b[q][2], b[q][3]); *(u32x4*)(XB + (size_t)ii * 8) = o; } } }
    float* COS = (float*)(ws + OFF_ROPE); float* SIN = COS + T_ * 16;
    for (int i = gt; i < T_ * 16; i += NGT) { const int t = i >> 4, k = i & 15; const float ang = (float)p.pos[t] * __builtin_amdgcn_exp2f(-1.1832230355827609f * (float)k);
        double rev = (double)ang * 0.15915494309189535; rev -= floor(rev); const float fr = (float)rev;
        COS[i] = __builtin_amdgcn_cosf(fr); SIN[i] = __builtin_amdgcn_sinf(fr); }
}

__device__ __forceinline__ void unpack8(const u32x4 w, float (&f)[8]) {
    f[0] = bf_lo(w.x); f[1] = bf_hi(w.x); f[2] = bf_lo(w.y); f[3] = bf_hi(w.y); f[4] = bf_lo(w.z); f[5] = bf_hi(w.z); f[6] = bf_lo(w.w); f[7] = bf_hi(w.w);
}
__device__ __forceinline__ void phase_mixer(const Params& p) {
    const bf16_t* Bq = (const bf16_t*)(p.ws + OFF_R + R_BIG); const bf16_t* CV = Bq + (size_t)T_ * DM; bf16_t* Y = (bf16_t*)(p.ws + OFF_R + R_SMALL);
    const int gt = blockIdx.x * NTHREADS + otid(), NGT = gridDim.x * NTHREADS;
    for (int id = gt; id < (T_ / 16) * 256; id += NGT) {
        const int cgp = id & 255, t0 = (id >> 8) * 16, ch = cgp * 8;
        float w0[8], w1[8], w2[8];
        { const f32x4 a = *(const f32x4*)(p.a_conv_w + ch), b = *(const f32x4*)(p.a_conv_w + ch + 4);
          w0[0] = a[0]; w0[1] = a[1]; w0[2] = a[2]; w0[3] = a[3]; w0[4] = b[0]; w0[5] = b[1]; w0[6] = b[2]; w0[7] = b[3]; }
        { const f32x4 a = *(const f32x4*)(p.a_conv_w + DM + ch), b = *(const f32x4*)(p.a_conv_w + DM + ch + 4);
          w1[0] = a[0]; w1[1] = a[1]; w1[2] = a[2]; w1[3] = a[3]; w1[4] = b[0]; w1[5] = b[1]; w1[6] = b[2]; w1[7] = b[3]; }
        { const f32x4 a = *(const f32x4*)(p.a_conv_w + 2 * DM + ch), b = *(const f32x4*)(p.a_conv_w + 2 * DM + ch + 4);
          w2[0] = a[0]; w2[1] = a[1]; w2[2] = a[2]; w2[3] = a[3]; w2[4] = b[0]; w2[5] = b[1]; w2[6] = b[2]; w2[7] = b[3]; }
        float m2[8], m1[8];
        if ((t0 & (SEQ - 1)) == 0) {
#pragma unroll
            for (int k = 0; k < 8; ++k) { m2[k] = 0.f; m1[k] = 0.f; }
        } else {
            unpack8(*(const u32x4*)(CV + (size_t)(t0 - 2) * DM + ch), m2); unpack8(*(const u32x4*)(CV + (size_t)(t0 - 1) * DM + ch), m1);
        }
#pragma unroll 4
        for (int r = 0; r < 16; ++r) {
            const size_t ro = (size_t)(t0 + r) * DM + ch;
            float b[8], cvv[8], y[8];
            unpack8(*(const u32x4*)(Bq + ro), b); unpack8(*(const u32x4*)(CV + ro), cvv);
#pragma unroll
            for (int k = 0; k < 8; ++k) { const float cv = cvv[k]; y[k] = b[k] * (w0[k] * m2[k] + w1[k] * m1[k] + w2[k] * cv); m2[k] = m1[k]; m1[k] = cv; }
            u32x4 o; o.x = pk2(y[0], y[1]); o.y = pk2(y[2], y[3]); o.z = pk2(y[4], y[5]); o.w = pk2(y[6], y[7]);
            *(u32x4*)(Y + (size_t)(t0 + r) * DM + ch) = o;
        }
    }
}

__device__ __forceinline__ void phase_ln(const float* Z, float* OUT, bf16_t* XB, const float* g, const float* b, float* ST) {
    constexpr int RPI = 4;
    const int lane = otid() & 63, gw = blockIdx.x * 8 + (otid() >> 6), NGW = gridDim.x * 8;
    for (int row0 = gw * RPI; row0 < T_; row0 += NGW * RPI) {
        f32x4 v[RPI][8]; float s[RPI], s2[RPI];
#pragma unroll
        for (int r = 0; r < RPI; ++r) { const f32x4* zr = (const f32x4*)(Z + (size_t)(row0 + r) * DM) + lane;
#pragma unroll
            for (int j = 0; j < 8; ++j) v[r][j] = zr[64 * j]; }
#pragma unroll
        for (int r = 0; r < RPI; ++r) { s[r] = 0.f;
#pragma unroll
            for (int j = 0; j < 8; ++j) s[r] += (v[r][j][0] + v[r][j][1]) + (v[r][j][2] + v[r][j][3]); }
#pragma unroll
        for (int r = 0; r < RPI; ++r) s[r] = wsum64(s[r], lane);
#pragma unroll
        for (int r = 0; r < RPI; ++r) { const float mean = s[r] * (1.f / DM); s[r] = mean; s2[r] = 0.f;
#pragma unroll
            for (int j = 0; j < 8; ++j) { v[r][j] = v[r][j] - mean; s2[r] += (v[r][j][0] * v[r][j][0] + v[r][j][1] * v[r][j][1]) + (v[r][j][2] * v[r][j][2] + v[r][j][3] * v[r][j][3]); } }
#pragma unroll
        for (int r = 0; r < RPI; ++r) s2[r] = wsum64(s2[r], lane);
        if (ST && lane == 0) {
#pragma unroll
            for (int r = 0; r < RPI; ++r) { ST[2 * (size_t)(row0 + r)] = s[r]; ST[2 * (size_t)(row0 + r) + 1] = 1.f / sqrtf(s2[r] * (1.f / DM) + LN_EPS); } }
#pragma unroll
        for (int j = 0; j < 8; ++j) { const f32x4 gg = ((const f32x4*)g)[lane + 64 * j], bb = ((const f32x4*)b)[lane + 64 * j];
#pragma unroll
            for (int r = 0; r < RPI; ++r) { const float rstd = 1.f / sqrtf(s2[r] * (1.f / DM) + LN_EPS);
                const f32x4 o = v[r][j] * rstd * gg + bb;
                if (OUT) ((f32x4*)(OUT + (size_t)(row0 + r) * DM) + lane)[64 * j] = o;
                if (XB) { u32x2 w; w.x = pk2(o[0], o[1]); w.y = pk2(o[2], o[3]); ((u32x2*)(XB + (size_t)(row0 + r) * DM) + lane)[64 * j] = w; } } }
    }
}

__device__ __forceinline__ f32x4 silu_mul(f32x4 gc, f32x4 uc) {
    f32x4 a;
#pragma unroll
    for (int j = 0; j < 4; ++j) a[j] = gc[j] * __builtin_amdgcn_rcpf(1.0f + __builtin_amdgcn_exp2f(-1.4426950408889634f * gc[j])) * uc[j];
    return a;
}
__device__ __forceinline__ void phase_fixup(const Params& p, const float* cw, const float* cb) {
    bf16_t* ACT = (bf16_t*)(p.ws + OFF_R + R_ACT); const bf16_t* HALO = (const bf16_t*)(p.ws + OFF_R + R_HALO);
    const int gt = blockIdx.x * NTHREADS + otid(), NGT = gridDim.x * NTHREADS;
    constexpr int NG = FF / 4;
    for (int id = gt; id < (T_ / 64) * NG; id += NGT) {
        const int blk = id / NG, ch = (id - blk * NG) * 4, cpg = (ch >> 7) * 256 + (ch & 127);
        const f32x4 z = {0.f, 0.f, 0.f, 0.f};
        const bool prev = (blk & 63) != 0;
        const bf16_t* hp = HALO + (size_t)(blk - 1) * 4 * NUP + cpg; const bf16_t* hc = HALO + (size_t)blk * 4 * NUP + cpg;
#define HL(ptr) ([](const bf16_t* q_) { const u32x2 w_ = *(const u32x2*)q_; return (f32x4){bf_lo(w_.x), bf_hi(w_.x), bf_lo(w_.y), bf_hi(w_.y)}; }(ptr))
        const f32x4 g_m2 = prev ? HL(hp) : z, g_m1 = prev ? HL(hp + NUP) : z, g_0 = HL(hc + 2 * NUP), g_1 = HL(hc + 3 * NUP);
        const f32x4 u_m2 = prev ? HL(hp + 128) : z, u_m1 = prev ? HL(hp + NUP + 128) : z, u_0 = HL(hc + 2 * NUP + 128), u_1 = HL(hc + 3 * NUP + 128);
        const f32x4 wg0 = *(const f32x4*)(cw + ch), wg1 = *(const f32x4*)(cw + NUP + ch), wg2 = *(const f32x4*)(cw + 2 * NUP + ch), bg = *(const f32x4*)(cb + ch);
        const f32x4 wu0 = *(const f32x4*)(cw + FF + ch), wu1 = *(const f32x4*)(cw + NUP + FF + ch), wu2 = *(const f32x4*)(cw + 2 * NUP + FF + ch), bu = *(const f32x4*)(cb + FF + ch);
        const f32x4 a0 = silu_mul(wg0 * g_m2 + wg1 * g_m1 + wg2 * g_0 + bg, wu0 * u_m2 + wu1 * u_m1 + wu2 * u_0 + bu);
        const f32x4 a1 = silu_mul(wg0 * g_m1 + wg1 * g_0 + wg2 * g_1 + bg, wu0 * u_m1 + wu1 * u_0 + wu2 * u_1 + bu);
        u32x2 w; w.x = pk2(a0[0], a0[1]); w.y = pk2(a0[2], a0[3]); *(u32x2*)(ACT + (size_t)(blk * 64) * FF + ch) = w;
        w.x = pk2(a1[0], a1[1]); w.y = pk2(a1[2], a1[3]); *(u32x2*)(ACT + (size_t)(blk * 64 + 1) * FF + ch) = w;
    }
}

__device__ __forceinline__ void phase_rope(const Params& p) {
    bf16_t* QKV = (bf16_t*)(p.ws + OFF_R + R_BIG); const float* COS = (const float*)(p.ws + OFF_ROPE); const float* SIN = COS + T_ * 16;
    const int gt = blockIdx.x * NTHREADS + otid(), NGT = gridDim.x * NTHREADS;
    for (int id = gt; id < T_ * 32; id += NGT) {
        const int t = id >> 5, grp = id & 31;
        bf16_t* base = QKV + (size_t)t * N6 + grp * 128;
        float x1[16], x2[16], c[16], s[16];
        { float tmp[8]; unpack8(*(const u32x4*)(base), tmp);
#pragma unroll
          for (int k = 0; k < 8; ++k) x1[k] = tmp[k];
          unpack8(*(const u32x4*)(base + 8), tmp);
#pragma unroll
          for (int k = 0; k < 8; ++k) x1[8 + k] = tmp[k];
          unpack8(*(const u32x4*)(base + 16), tmp);
#pragma unroll
          for (int k = 0; k < 8; ++k) x2[k] = tmp[k];
          unpack8(*(const u32x4*)(base + 24), tmp);
#pragma unroll
          for (int k = 0; k < 8; ++k) x2[8 + k] = tmp[k]; }
#pragma unroll
        for (int q = 0; q < 4; ++q) { const f32x4 cc = *(const f32x4*)(COS + t * 16 + 4 * q), ss = *(const f32x4*)(SIN + t * 16 + 4 * q);
#pragma unroll
            for (int k = 0; k < 4; ++k) { c[4 * q + k] = cc[k]; s[4 * q + k] = ss[k]; } }
        float n1[16], n2[16];
#pragma unroll
        for (int k = 0; k < 16; ++k) { n1[k] = x1[k] * c[k] - x2[k] * s[k]; n2[k] = x2[k] * c[k] + x1[k] * s[k]; }
        u32x4 o;
        o.x = pk2(n1[0], n1[1]); o.y = pk2(n1[2], n1[3]); o.z = pk2(n1[4], n1[5]); o.w = pk2(n1[6], n1[7]); *(u32x4*)(base) = o;
        o.x = pk2(n1[8], n1[9]); o.y = pk2(n1[10], n1[11]); o.z = pk2(n1[12], n1[13]); o.w = pk2(n1[14], n1[15]); *(u32x4*)(base + 8) = o;
        o.x = pk2(n2[0], n2[1]); o.y = pk2(n2[2], n2[3]); o.z = pk2(n2[4], n2[5]); o.w = pk2(n2[6], n2[7]); *(u32x4*)(base + 16) = o;
        o.x = pk2(n2[8], n2[9]); o.y = pk2(n2[10], n2[11]); o.z = pk2(n2[12], n2[13]); o.w = pk2(n2[14], n2[15]); *(u32x4*)(base + 24) = o;
    }
}

typedef att::BlockRef<att::bf16, att::bf16> ABlock;
__device__ __forceinline__ ABlock attn_ref(const att::bf16* QKV, att::bf16* AO0, att::bf16* AO1, int L, int pass) {
    const int i = L >> 8, wl = L & 255, bh = i * 8 + (wl & 7), sub = wl >> 3, c = sub >> 4, e = (sub >> 3) & 1, x = sub & 7;
    const int b = bh >> 3, h = bh & 7, qb = pass ? 15 - x : x;
    ABlock r;
    const size_t row0 = (size_t)b * SEQ;
    r.Q = QKV + (row0 + (size_t)qb * 256) * N6 + h * 256 + c * 128;
    r.K = QKV + row0 * N6 + DM + h * 256 + c * 128;
    r.V = QKV + row0 * N6 + 2 * DM + h * 256 + e * 128;
    r.O = (c ? AO1 : AO0) + (row0 + (size_t)qb * 256) * DM + h * 256 + e * 128;
    r.P0 = qb * 256;
    return r;
}
__device__ __forceinline__ void phase_attn(const Params& p, char* lds) {
    const att::bf16* QKV = (const att::bf16*)(p.ws + OFF_R + R_BIG); att::bf16* AO0 = (att::bf16*)(p.ws + OFF_R + R_SMALL); att::bf16* AO1 = (att::bf16*)(p.ws + OFF_XB);
    constexpr int TOTAL = 1024; const int stride = gridDim.x;
    int L = blockIdx.x; if (L >= TOTAL) return;
    int pass = 0;
    ABlock cur = attn_ref(QKV, AO0, AO1, L, 0);
    att::Seam<att::bf16> S;
    att::causal_swa_prime<att::bf16, att::bf16>(cur, SEQ, lds, S);
    for (;;) {
        const bool more_pass = pass == 0, more_item = L + stride < TOTAL, last = !more_pass && !more_item;
        int passn = pass + 1, Ln = L;
        if (!more_pass) { passn = 0; Ln = more_item ? L + stride : L; }
        const ABlock nxt = last ? cur : attn_ref(QKV, AO0, AO1, Ln, passn);
        att::causal_swa_block<att::bf16, att::bf16>(cur, nxt, SEQ, SEQ, lds, S);
        if (last) break;
        cur = nxt; pass = passn; L = Ln;
    }
}

__device__ __forceinline__ void phase_combine(const Params& p) {
    bf16_t* AO0 = (bf16_t*)(p.ws + OFF_R + R_SMALL); const bf16_t* AO1 = (const bf16_t*)(p.ws + OFF_XB);
    const int lane = otid() & 63, gw = blockIdx.x * 8 + (otid() >> 6), NGW = gridDim.x * 8;
    const float s01 = wave_sum(p.lam[lane] * p.lam[128 + lane] + p.lam[64 + lane] * p.lam[192 + lane], lane);
    const float s23 = wave_sum(p.lam[256 + lane] * p.lam[384 + lane] + p.lam[320 + lane] * p.lam[448 + lane], lane);
    const float lam = __builtin_amdgcn_exp2f(1.4426950408889634f * s01) - __builtin_amdgcn_exp2f(1.4426950408889634f * s23) + LAMBDA_INIT;
    float gs[8];
    { const f32x4 a = *(const f32x4*)(p.subln_g + (lane & 31) * 8), b = *(const f32x4*)(p.subln_g + (lane & 31) * 8 + 4);
      gs[0] = a[0]; gs[1] = a[1]; gs[2] = a[2]; gs[3] = a[3]; gs[4] = b[0]; gs[5] = b[1]; gs[6] = b[2]; gs[7] = b[3];
#pragma unroll
      for (int k = 0; k < 8; ++k) gs[k] *= (1.0f - LAMBDA_INIT); }
    constexpr int RPI = 4;
    for (int row0 = gw * RPI; row0 < T_; row0 += NGW * RPI) {
        u32x4 va[RPI][4], vb[RPI][4];
#pragma unroll
        for (int r = 0; r < RPI; ++r) { const u32x4* r0 = (const u32x4*)(AO0 + (size_t)(row0 + r) * DM) + lane; const u32x4* r1 = (const u32x4*)(AO1 + (size_t)(row0 + r) * DM) + lane;
#pragma unroll
            for (int j = 0; j < 4; ++j) { va[r][j] = r0[64 * j]; vb[r][j] = r1[64 * j]; } }
#pragma unroll
        for (int r = 0; r < RPI; ++r) { u32x4* r0 = (u32x4*)(AO0 + (size_t)(row0 + r) * DM) + lane;
#pragma unroll
            for (int j = 0; j < 4; ++j) {
                float a[8], b[8], o[8]; unpack8(va[r][j], a); unpack8(vb[r][j], b);
                float ss = 0.f;
#pragma unroll
                for (int k = 0; k < 8; ++k) { o[k] = a[k] - lam * b[k]; ss += o[k] * o[k]; }
                ss = xadd<1>(ss, lane); ss = xadd<2>(ss, lane); ss = xadd<4>(ss, lane); ss = xadd<8>(ss, lane); ss = xadd<16>(ss, lane);
                const float rstd = 1.f / sqrtf(ss * (1.f / 256.f) + SUBLN_EPS);
                u32x4 w; w.x = pk2(o[0] * rstd * gs[0], o[1] * rstd * gs[1]); w.y = pk2(o[2] * rstd * gs[2], o[3] * rstd * gs[3]);
                w.z = pk2(o[4] * rstd * gs[4], o[5] * rstd * gs[5]); w.w = pk2(o[6] * rstd * gs[6], o[7] * rstd * gs[7]);
                r0[64 * j] = w;
            } }
    }
}

#define XB_TMO      128
#define XB_XCNT(j)  (256  + 64 * (j))
#define XB_XSUB(j)  (1280 + 64 * (j))
#define XB_XGEN(j)  (2304 + 64 * (j))
#define XB_TOP      3328
#define XB_TOPGEN   3392
#define XCD_BAR_WORDS 3456
#define XB_SPIN_CAP (1u << 18)
__device__ __forceinline__ unsigned xb_ld(unsigned* p)              { return __hip_atomic_load(p, __ATOMIC_RELAXED, __HIP_MEMORY_SCOPE_AGENT); }
__device__ __forceinline__ unsigned xb_add(unsigned* p, unsigned v) { return __hip_atomic_fetch_add(p, v, __ATOMIC_RELAXED, __HIP_MEMORY_SCOPE_AGENT); }
__device__ __forceinline__ unsigned xb_xcc_id() { return (unsigned)__builtin_amdgcn_s_getreg((3 << 11) | 20) & 0xFu; }
#define XB_SPIN(cond, bar) do { unsigned _sp = 0; while (cond) { __builtin_amdgcn_s_sleep(1); \
    if ((++_sp & 255u) == 0u) { if (xb_ld(&(bar)[XB_TMO])) break; if (_sp > XB_SPIN_CAP) { atomicAdd(&(bar)[XB_TMO], 1u); break; } } } } while (0)

struct XcdBarrier {
    unsigned* bar; unsigned x;
    volatile LAS unsigned* st;
};

__device__ __forceinline__ XcdBarrier xcd_barrier_post(unsigned* bar, volatile LAS unsigned* st) {
    XcdBarrier b; b.bar = bar; b.x = xb_xcc_id(); b.st = st;
    if (otid() == 0) (void)xb_add(&bar[XB_XCNT(b.x)], 1u);
    return b;
}
__device__ __forceinline__ void xcd_barrier_complete(unsigned* bar, unsigned x, unsigned& nloc, unsigned& nx) {
    const unsigned G = gridDim.x * gridDim.y * gridDim.z;
    unsigned sum, cnt, mine, sp = 0u;
    for (;;) {
        sum = 0u; cnt = 0u; mine = 0u;
#pragma unroll
        for (unsigned j = 0; j < 16; ++j) { const unsigned c = xb_ld(&bar[XB_XCNT(j)]); sum += c; cnt += (c > 0u) ? 1u : 0u; mine = (j == x) ? c : mine; }
        if (sum == G) break;
        __builtin_amdgcn_s_sleep(1);
        if ((++sp & 255u) == 0u) { if (xb_ld(&bar[XB_TMO])) break; if (sp > XB_SPIN_CAP) { atomicAdd(&bar[XB_TMO], 1u); break; } }
    }
    nloc = mine > 0u ? mine : 1u; nx = cnt > 0u ? cnt : 1u;
}

__device__ __forceinline__ void xcd_barrier(const XcdBarrier& b) {
    asm volatile("s_waitcnt vmcnt(0)" ::: "memory");
    __syncthreads();
    if (otid() == 0) {
        unsigned* bar = b.bar;
        __builtin_amdgcn_s_waitcnt(0);
        unsigned nloc = b.st[0], nx = b.st[1];
        if (nloc == 0u) { xcd_barrier_complete(bar, b.x, nloc, nx); b.st[0] = nloc; b.st[1] = nx; }
        const unsigned old = xb_add(&bar[XB_XSUB(b.x)], 1u);
        const unsigned gen = old / nloc;
        if (old + 1u == (gen + 1u) * nloc) {
            __builtin_amdgcn_fence(__ATOMIC_RELEASE, "agent");
            asm volatile("s_waitcnt vmcnt(0)" ::: "memory");
            const unsigned og = xb_add(&bar[XB_TOP], 1u);
            const unsigned tg = og / nx;
            if (og + 1u == (tg + 1u) * nx) xb_add(&bar[XB_TOPGEN], 1u);
            else XB_SPIN(xb_ld(&bar[XB_TOPGEN]) == tg, bar);
            __builtin_amdgcn_fence(__ATOMIC_ACQUIRE, "agent");
            xb_add(&bar[XB_XGEN(b.x)], 1u);
            asm volatile("s_waitcnt vmcnt(0)" ::: "memory");
        } else {
            XB_SPIN(xb_ld(&bar[XB_XGEN(b.x)]) == gen, bar);
            __builtin_amdgcn_fence(__ATOMIC_ACQUIRE, "agent");
            asm volatile("s_waitcnt vmcnt(0)" ::: "memory");
        }
    }
    __syncthreads();
}

template <int layer>
__device__ __forceinline__ void layer_body(const Params& p, LAS unsigned char* ldsl, unsigned char* lds, const XcdBarrier& bar, const int G, const int c) {
        unsigned char* ws = p.ws; float* Z = (float*)(ws + OFF_Z); bf16_t* XB = (bf16_t*)(ws + OFF_XB);
        if constexpr (layer == 0) {
            { pg8::Gemm g{XB, (const bf16_t*)(ws + OFF_WIN), T_, 2 * DM, DM}; pg8::StaticOrder S; S.init(T_, 2 * DM, G, c);
              pg8::EpiGateCV E{(bf16_t*)(ws + OFF_R + R_BIG), (bf16_t*)(ws + OFF_R + R_BIG) + (size_t)T_ * DM};
              pg8::gemm_phase<pg8::EpiGateCV, pg8::StaticOrder, PG8_ALIGN, PG8_SP2>(ldsl, g, S, E); }
            xcd_barrier(bar);
            { pg8::Gemm g{XB, (const bf16_t*)(ws + OFF_WIN) + (size_t)2 * DM * DM, T_, DM, DM}; pg8::StaticOrder S; S.init(T_, DM, G, c);
              pg8::EpiMix E{(const bf16_t*)(ws + OFF_R + R_BIG) + (size_t)T_ * DM, (bf16_t*)(ws + OFF_R + R_SMALL), p.a_conv_w};
              pg8::gemm_phase<pg8::EpiMix, pg8::StaticOrder, PG8_ALIGN, PG8_SP2>(ldsl, g, S, E); }
            xcd_barrier(bar);
        } else {
            { pg8::Gemm g{XB, (const bf16_t*)(ws + OFF_WQKV), T_, N6, DM}; pg8::StaticOrder S; S.init(T_, N6, G, c);
              pg8::EpiBf16P E{(bf16_t*)(ws + OFF_R + R_BIG), N6, (const float*)(ws + OFF_ROPE), (const float*)(ws + OFF_ROPE) + T_ * 16};
              pg8::gemm_phase<pg8::EpiBf16P, pg8::StaticOrder, PG8_ALIGN, PG8_SP2>(ldsl, g, S, E); }
            xcd_barrier(bar);
            phase_attn(p, (char*)lds); xcd_barrier(bar); phase_combine(p); xcd_barrier(bar);
        }
        { pg8::Gemm g{(const bf16_t*)(ws + OFF_R + R_SMALL), (const bf16_t*)(ws + (layer ? OFF_WO : OFF_WOUT)), T_, DM, DM}; pg8::StaticOrder S; S.init(T_, DM, G, c);
          pg8::EpiResF32 E{layer ? (const float*)Z : p.x, Z, DM, ALPHA, layer ? (const float*)LNST(1) : nullptr, p.ln_g + DM, p.ln_b + DM};
          pg8::gemm_phase<pg8::EpiResF32, pg8::StaticOrder, PG8_ALIGN, PG8_SP2>(ldsl, g, S, E); }
        xcd_barrier(bar);
        phase_ln(Z, nullptr, XB, p.ln_g + (size_t)(layer * 2) * DM, p.ln_b + (size_t)(layer * 2) * DM, LNST(layer * 2));
        xcd_barrier(bar);
        const float* cw = p.ffn_cw + (size_t)layer * 3 * NUP; const float* cb = p.ffn_cb + (size_t)layer * NUP;
        { pg8::Gemm g{XB, (const bf16_t*)(ws + (layer ? OFF_WUP1 : OFF_WUP0)), T_, NUP, DM}; pg8::StaticOrder S; S.init(T_, NUP, G, c);
          pg8::EpiConvGate E{(bf16_t*)(ws + OFF_R + R_ACT), (bf16_t*)(ws + OFF_R + R_HALO), cw, cb};
          pg8::gemm_phase<pg8::EpiConvGate, pg8::StaticOrder, PG8_ALIGN, PG8_SP2>(ldsl, g, S, E); }
        xcd_barrier(bar);
        phase_fixup(p, cw, cb);
        xcd_barrier(bar);
        { pg8::Gemm g{(const bf16_t*)(ws + OFF_R + R_ACT), (const bf16_t*)(ws + (layer ? OFF_WDN1 : OFF_WDN0)), T_, DM, FF}; pg8::StaticOrder S; S.init(T_, DM, G, c);
          pg8::EpiResF32 E{Z, Z, DM, ALPHA, LNST(layer * 2), p.ln_g + (size_t)(layer * 2) * DM, p.ln_b + (size_t)(layer * 2) * DM};
          pg8::gemm_phase<pg8::EpiResF32, pg8::StaticOrder, PG8_ALIGN, PG8_SP2>(ldsl, g, S, E); }
        xcd_barrier(bar);
        phase_ln(Z, layer ? p.out : nullptr, layer ? nullptr : XB, p.ln_g + (size_t)(layer * 2 + 1) * DM, p.ln_b + (size_t)(layer * 2 + 1) * DM, layer ? nullptr : LNST(1));
        if (layer == 0) xcd_barrier(bar);
    }

__global__ void __launch_bounds__(NTHREADS, 2) fwd_megakernel(Params p) {
    extern __shared__ __attribute__((aligned(16))) unsigned char lds[];
    cg::grid_group grid = cg::this_grid();
    LAS unsigned char* ldsl = (LAS unsigned char*)lds;
    unsigned char* ws = p.ws;
    float* Z = (float*)(ws + OFF_Z); bf16_t* XB = (bf16_t*)(ws + OFF_XB);
    const int G = gridDim.x, c = blockIdx.x;

    volatile LAS unsigned* st = (volatile LAS unsigned*)(ldsl + LDS_STAGE);
    { const int t0 = threadIdx.x; if ((t0 & 63) == 0) ((volatile LAS int*)(ldsl + WTAB_OFF))[hwslot()] = t0 >> 6; if (t0 < 4) st[t0] = 0u; }
    __syncthreads();
    const XcdBarrier bar = xcd_barrier_post((unsigned*)(ws + OFF_BAR), st);
    phase_prologue(p, ldsl);
    if (gridDim.x == 0x7fffffffu) grid.sync();
    xcd_barrier(bar);
    layer_body<0>(p, ldsl, lds, bar, G, c);
    layer_body<1>(p, ldsl, lds, bar, G, c);
}

extern "C" void kernel_launch(void* const* d_in, const int* in_sizes, int n_in, void* d_out, int out_size, void* d_ws, size_t ws_size, hipStream_t stream) {
    static int grid = 0;
    if (grid == 0) {
        if (n_in != 17 || in_sizes[0] != T_ * DM || out_size != T_ * DM || ws_size < WS_END) {
            fprintf(stderr, "kernel_launch: unexpected shapes (n_in %d, in0 %d, out %d, ws %zu, need %zu)\n", n_in, n_in > 0 ? in_sizes[0] : -1, out_size, ws_size, (size_t)WS_END); grid = -1; return; }
        int dev = 0, cus = 0, per_cu = 0;
        (void)hipGetDevice(&dev); (void)hipDeviceGetAttribute(&cus, hipDeviceAttributeMultiprocessorCount, dev);
        if (hipFuncSetAttribute((const void*)fwd_megakernel, hipFuncAttributeMaxDynamicSharedMemorySize, LDS_BYTES) != hipSuccess) { fprintf(stderr, "kernel_launch: hipFuncSetAttribute failed\n"); grid = -1; return; }
        if (hipOccupancyMaxActiveBlocksPerMultiprocessor(&per_cu, (const void*)fwd_megakernel, NTHREADS, LDS_BYTES) != hipSuccess || per_cu < 1) { fprintf(stderr, "kernel_launch: occupancy query says %d\n", per_cu); per_cu = 1; }
        (void)hipGetLastError();
        if (cus <= 0) cus = 256;
        grid = cus;
    }
    if (grid < 0) return;
    Params p{};
    p.x = (const float*)d_in[0]; p.pos = (const int*)d_in[1]; p.ln_g = (const float*)d_in[2]; p.ln_b = (const float*)d_in[3];
    p.a_w_in = (const float*)d_in[4]; p.a_conv_w = (const float*)d_in[5]; p.a_w_out = (const float*)d_in[6];
    p.w_k = (const float*)d_in[7]; p.w_v = (const float*)d_in[8]; p.w_q = (const float*)d_in[9]; p.lam = (const float*)d_in[10];
    p.subln_g = (const float*)d_in[11]; p.w_o = (const float*)d_in[12]; p.w_up = (const float*)d_in[13]; p.ffn_cw = (const float*)d_in[14];
    p.ffn_cb = (const float*)d_in[15]; p.w_dn = (const float*)d_in[16];
    p.out = (float*)d_out; p.ws = (unsigned char*)d_ws;
    (void)hipMemsetAsync((unsigned char*)d_ws + OFF_BAR, 0, XCD_BAR_WORDS * 4, stream);
    void* args[] = {&p};
    hipError_t e = hipLaunchCooperativeKernel((const void*)fwd_megakernel, dim3(grid), dim3(NTHREADS), args, LDS_BYTES, stream);
    if (e != hipSuccess) fprintf(stderr, "kernel_launch: cooperative launch failed: %s (grid %d)\n", hipGetErrorString(e), grid);
}
```

```cpp
#include <hip/hip_runtime.h>
#include <hip/hip_bf16.h>
#include <hip/hip_cooperative_groups.h>
#include <cstdio>
#include <cstdint>
namespace cg = cooperative_groups;

extern __shared__ __attribute__((aligned(16))) unsigned char g_lds[];
constexpr int WTAB_OFF = 131072 + 16, HTAB_OFF = 131072 + 16 + 256;
__device__ __forceinline__ int olane() { int l; asm volatile("v_mbcnt_lo_u32_b32 %0, -1, 0\n\tv_mbcnt_hi_u32_b32 %0, -1, %0" : "=v"(l)); return l; }
template <int M> __device__ __forceinline__ float swz_xor(float v, int lane) { return __builtin_bit_cast(float, __builtin_amdgcn_ds_bpermute((lane ^ M) << 2, __builtin_bit_cast(int, v))); }
template <int M> __device__ __forceinline__ float xadd(float v, int lane) { return v + swz_xor<M>(v, lane); }
__device__ __forceinline__ float wsum64(float v, int lane) { v = xadd<1>(v, lane); v = xadd<2>(v, lane); v = xadd<4>(v, lane); v = xadd<8>(v, lane); v = xadd<16>(v, lane); return xadd<32>(v, lane); }
__device__ __forceinline__ unsigned hwslot() { return (unsigned)__builtin_amdgcn_s_getreg((5 << 11) | 4) & 63u; }
__device__ __forceinline__ int otid() {
    const int wid = __builtin_amdgcn_readfirstlane(((volatile __attribute__((address_space(3))) int*)(g_lds + WTAB_OFF))[hwslot()]);
    return wid * 64 + olane();
}
#ifndef PG8_ALIGN
#define PG8_ALIGN true
#endif
#ifndef PG8_SP2
#define PG8_SP2 true
#endif
namespace pg8 {
#define PG8_LAS __attribute__((address_space(3)))
typedef unsigned short bf16_t;
typedef short bf16x8 __attribute__((ext_vector_type(8)));
typedef float f32x4 __attribute__((ext_vector_type(4)));
typedef unsigned u32x4 __attribute__((ext_vector_type(4)));
constexpr int BM = 256, BK = 64, HALF = 128, HTB = HALF * BK * 2  , STAGE_BYTES = 8 * HTB, NXCD = 8, WGM = 8;

__host__ __device__ __forceinline__ int lds_byte(int r, int c) { const int st = (r >> 4) * 2 + (c >> 5), rr = r & 15, cc = c & 31, ob = rr * 64 + cc * 2; return st * 1024 + (ob ^ (((ob >> 9) & 1) << 5)); }
__host__ __device__ __forceinline__ void stage_rc(int b, int& R, int& C) { const int st = b / 1024, sb = b % 1024, swz = sb ^ (((sb >> 9) & 1) << 5); R = (st >> 1) * 16 + swz / 64; C = (st & 1) * 32 + (swz % 64) / 2; }
__host__ __device__ __forceinline__ int perm32(int rho) { const int n = rho >> 4, i = rho & 15; return 8 * (i >> 2) + 4 * n + (i & 3); }

struct Unit { int pm, pn; };
struct Gemm { const bf16_t* A; const bf16_t* Bt; int M, N, K; };

struct StaticOrder {
    int nM, nN, nwg, G, c;
    __host__ __device__ void init(int M, int N, int G_, int c_) { nM = M / BM; nN = N / BM; nwg = nM * nN; G = G_; c = c_; }
    __host__ __device__ bool next(int i, Unit& u) const {
        const long L = (long)i * G + c; if (L >= nwg) return false;
        int wgid = (int)L; { const int q = nwg / NXCD, r = nwg % NXCD, xcd = wgid % NXCD, off = wgid / NXCD; wgid = (xcd < r ? xcd * (q + 1) : r * (q + 1) + (xcd - r) * q) + off; }
        const int nig = WGM * nN, gid = wgid / nig, fm = gid * WGM, gsz = (nM - fm) < WGM ? (nM - fm) : WGM;
        u.pm = fm + ((wgid % nig) % gsz); u.pn = (wgid % nig) / gsz; return true;
    }
    __device__ __forceinline__ void a_ready(const Unit&) const {}
    __device__ __forceinline__ void done(const Unit&) const {}
};
__device__ __forceinline__ unsigned cvt_pk_bf16(float lo, float hi) { unsigned r; asm volatile("v_cvt_pk_bf16_f32 %0, %1, %2" : "=v"(r) : "v"(lo), "v"(hi)); return r; }
typedef unsigned u32x2 __attribute__((ext_vector_type(2)));
typedef float f32x2 __attribute__((ext_vector_type(2)));
struct EpiBf16P {
    static constexpr bool PERM = true, AFTER_DRAIN = false;
    bf16_t* O; int ldc;
    const float* rcos; const float* rsin;
    static __device__ __forceinline__ float pull(int addr, float v) { return __builtin_bit_cast(float, __builtin_amdgcn_ds_bpermute(addr, __builtin_bit_cast(int, v))); }
    __device__ __forceinline__ void operator()(const f32x4 (&acc)[2][2][4][2], const Unit& u, int wr, int wc, int fr, int fq) const {
        const int row0 = u.pm * BM + wr * 64 + fr, col0 = u.pn * BM + wc * 32 + 8 * fq;
        const bool rope = rcos != nullptr && wc == 0 && u.pn < 16;
        const int plane = ((fq * 16 + fr) ^ 32) << 2; const float sgn = fq < 2 ? -1.f : 1.f;
#pragma unroll
        for (int ai = 0; ai < 2; ++ai)
#pragma unroll
            for (int m = 0; m < 4; ++m) { const int row = row0 + ai * HALF + m * 16; bf16_t* rowp = O + (size_t)row * ldc + col0;
                f32x4 c0, c1, s0, s1;
                if (rope) { const float* cp = rcos + (size_t)row * 16 + 8 * (fq & 1); const float* sp = rsin + (size_t)row * 16 + 8 * (fq & 1);
                    c0 = *(const f32x4*)cp; c1 = *(const f32x4*)(cp + 4); s0 = *(const f32x4*)sp * sgn; s1 = *(const f32x4*)(sp + 4) * sgn; }
#pragma unroll
                for (int bj = 0; bj < 2; ++bj) { f32x4 v0 = acc[ai][bj][m][0], v1 = acc[ai][bj][m][1];
                    if (rope) { f32x4 p0, p1;
                        p0[0] = pull(plane, v0[0]); p0[1] = pull(plane, v0[1]); p0[2] = pull(plane, v0[2]); p0[3] = pull(plane, v0[3]);
                        p1[0] = pull(plane, v1[0]); p1[1] = pull(plane, v1[1]); p1[2] = pull(plane, v1[2]); p1[3] = pull(plane, v1[3]);
                        v0 = v0 * c0 + p0 * s0; v1 = v1 * c1 + p1 * s1; }
                    u32x4 w; w.x = cvt_pk_bf16(v0[0], v0[1]); w.y = cvt_pk_bf16(v0[2], v0[3]); w.z = cvt_pk_bf16(v1[0], v1[1]); w.w = cvt_pk_bf16(v1[2], v1[3]);
                    *(u32x4*)(rowp + bj * HALF) = w; } }
    }
};
struct EpiGateCV {
    static constexpr bool PERM = true, AFTER_DRAIN = false;
    bf16_t* Bq; bf16_t* CV;
    __device__ __forceinline__ void operator()(const f32x4 (&acc)[2][2][4][2], const Unit& u, int wr, int wc, int fr, int fq) const {
        const int row0 = u.pm * BM + wr * 64 + fr;
        if (u.pn < 16) {
            const int c0 = u.pn * 128 + wc * 32 + 8 * fq;
#pragma unroll
            for (int ai = 0; ai < 2; ++ai)
#pragma unroll
                for (int m = 0; m < 4; ++m) { const f32x4 v0 = acc[ai][0][m][0] * acc[ai][1][m][0], v1 = acc[ai][0][m][1] * acc[ai][1][m][1];
                    u32x4 w; w.x = cvt_pk_bf16(v0[0], v0[1]); w.y = cvt_pk_bf16(v0[2], v0[3]); w.z = cvt_pk_bf16(v1[0], v1[1]); w.w = cvt_pk_bf16(v1[2], v1[3]);
                    *(u32x4*)(CV + (size_t)(row0 + ai * HALF + m * 16) * 2048 + c0) = w; }
        } else {
            const int c0 = (u.pn - 16) * BM + wc * 32 + 8 * fq;
#pragma unroll
            for (int ai = 0; ai < 2; ++ai)
#pragma unroll
                for (int m = 0; m < 4; ++m) { bf16_t* rowp = Bq + (size_t)(row0 + ai * HALF + m * 16) * 2048 + c0;
#pragma unroll
                    for (int bj = 0; bj < 2; ++bj) { const f32x4 v0 = acc[ai][bj][m][0], v1 = acc[ai][bj][m][1];
                        u32x4 w; w.x = cvt_pk_bf16(v0[0], v0[1]); w.y = cvt_pk_bf16(v0[2], v0[3]); w.z = cvt_pk_bf16(v1[0], v1[1]); w.w = cvt_pk_bf16(v1[2], v1[3]);
                        *(u32x4*)(rowp + bj * HALF) = w; } }
        }
    }
};
struct EpiResF32 {
    static constexpr bool PERM = false, AFTER_DRAIN = false;
    const float* base; float* out; int ldc; float alpha;
    const float* pstat; const float* pg; const float* pb;
    __device__ __forceinline__ void operator()(const f32x4 (&acc)[2][2][4][2], const Unit& u, int wr, int wc, int fr, int fq) const {
        typedef f32x4 __attribute__((address_space(1))) gf4; typedef f32x2 __attribute__((address_space(1))) gf2;
        const float __attribute__((address_space(1)))* const bp = (const float __attribute__((address_space(1)))*)base;
        float __attribute__((address_space(1)))* const op = (float __attribute__((address_space(1)))*)out;
        const float __attribute__((address_space(1)))* const sp = (const float __attribute__((address_space(1)))*)pstat;
        const float __attribute__((address_space(1)))* const gp = (const float __attribute__((address_space(1)))*)pg;
        const float __attribute__((address_space(1)))* const bbp = (const float __attribute__((address_space(1)))*)pb;
        const int row0 = u.pm * BM + wr * 64 + fr, col0 = u.pn * BM + wc * 32 + 4 * fq;
        f32x2 st[2][4];
        if (sp) {
#pragma unroll
            for (int ai = 0; ai < 2; ++ai)
#pragma unroll
                for (int m = 0; m < 4; ++m) st[ai][m] = *(const gf2*)(sp + (unsigned)(2 * (row0 + ai * HALF + m * 16)));
        }
#pragma unroll
        for (int bj = 0; bj < 2; ++bj)
#pragma unroll
            for (int n = 0; n < 2; ++n) {
                const int cc = col0 + bj * HALF + n * 16;
                f32x4 gv, bv; if (sp) { gv = *(const gf4*)(gp + cc); bv = *(const gf4*)(bbp + cc); }
                f32x4 bs[2][4];
#pragma unroll
                for (int ai = 0; ai < 2; ++ai)
#pragma unroll
                    for (int m = 0; m < 4; ++m) bs[ai][m] = *(const gf4*)(bp + (unsigned)((row0 + ai * HALF + m * 16) * ldc + cc));
#pragma unroll
                for (int ai = 0; ai < 2; ++ai)
#pragma unroll
                    for (int m = 0; m < 4; ++m) { f32x4 x = bs[ai][m];
                        if (sp) x = (x - st[ai][m].x) * st[ai][m].y * gv + bv;
                        *(gf4*)(op + (unsigned)((row0 + ai * HALF + m * 16) * ldc + cc)) = x * alpha + acc[ai][bj][m][n]; }
                asm volatile("" ::: "memory"); }
    }
};
struct EpiMix {
    static constexpr bool PERM = true, AFTER_DRAIN = false;
    const bf16_t* CV; bf16_t* Y; const float* cw;
    static __device__ __forceinline__ void up8(const u32x4 w, f32x4& lo, f32x4& hi) {
        lo = (f32x4){__uint_as_float(w.x << 16), __uint_as_float(w.x & 0xffff0000u), __uint_as_float(w.y << 16), __uint_as_float(w.y & 0xffff0000u)};
        hi = (f32x4){__uint_as_float(w.z << 16), __uint_as_float(w.z & 0xffff0000u), __uint_as_float(w.w << 16), __uint_as_float(w.w & 0xffff0000u)}; }
    __device__ __forceinline__ void operator()(const f32x4 (&acc)[2][2][4][2], const Unit& u, int wr, int wc, int fr, int fq) const {
        typedef u32x4 __attribute__((address_space(1))) gu4; typedef f32x4 __attribute__((address_space(1))) gf4;
        const bf16_t __attribute__((address_space(1)))* const cvp = (const bf16_t __attribute__((address_space(1)))*)CV;
        bf16_t __attribute__((address_space(1)))* const yp = (bf16_t __attribute__((address_space(1)))*)Y;
        const float __attribute__((address_space(1)))* const wp = (const float __attribute__((address_space(1)))*)cw;
        const int row0 = u.pm * BM + wr * 64 + fr;
#pragma unroll
        for (int bj = 0; bj < 2; ++bj) {
            const int ch = u.pn * BM + bj * HALF + wc * 32 + 8 * fq;
            const f32x4 w0a = *(const gf4*)(wp + ch), w0b = *(const gf4*)(wp + ch + 4), w1a = *(const gf4*)(wp + 2048 + ch), w1b = *(const gf4*)(wp + 2048 + ch + 4),
                        w2a = *(const gf4*)(wp + 4096 + ch), w2b = *(const gf4*)(wp + 4096 + ch + 4);
#pragma unroll
            for (int ai = 0; ai < 2; ++ai) {
                u32x4 c0[4], c1[4], c2[4];
#pragma unroll
                for (int m = 0; m < 4; ++m) { const int t = row0 + ai * HALF + m * 16; const unsigned off = (unsigned)(t * 2048 + ch);
                    c0[m] = *(const gu4*)(cvp + off);
                    c1[m] = (t & 4095) >= 1 ? *(const gu4*)(cvp + off - 2048) : (u32x4){0u, 0u, 0u, 0u};
                    c2[m] = (t & 4095) >= 2 ? *(const gu4*)(cvp + off - 4096) : (u32x4){0u, 0u, 0u, 0u}; }
#pragma unroll
                for (int m = 0; m < 4; ++m) { const int t = row0 + ai * HALF + m * 16;
                    f32x4 a0, b0, a1, b1, a2, b2; up8(c0[m], a0, b0); up8(c1[m], a1, b1); up8(c2[m], a2, b2);
                    const f32x4 ya = acc[ai][bj][m][0] * (w0a * a2 + w1a * a1 + w2a * a0), yb = acc[ai][bj][m][1] * (w0b * b2 + w1b * b1 + w2b * b0);
                    u32x4 w; w.x = cvt_pk_bf16(ya[0], ya[1]); w.y = cvt_pk_bf16(ya[2], ya[3]); w.z = cvt_pk_bf16(yb[0], yb[1]); w.w = cvt_pk_bf16(yb[2], yb[3]);
                    *(gu4*)(yp + (unsigned)(t * 2048 + ch)) = w; }
            }
        }
    }
};
template <int CTRL> __device__ __forceinline__ float dpp_ror(float v) { return __builtin_bit_cast(float, __builtin_amdgcn_update_dpp(0, __builtin_bit_cast(int, v), CTRL, 0xF, 0xF, false)); }
struct EpiConvGate {
    static constexpr bool PERM = true, AFTER_DRAIN = false;
    bf16_t* ACT; float* HALO; const float* cw; const float* cb;
    __device__ __forceinline__ void operator()(const f32x4 (&acc)[2][2][4][2], const Unit& u, int wr, int wc, int fr, int fq) const {
        constexpr int FF_ = 5632, N2 = 2 * FF_;
        typedef f32x4 __attribute__((address_space(1))) gf4; typedef u32x2 __attribute__((address_space(1))) gu2;
        const float __attribute__((address_space(1)))* const cwp = (const float __attribute__((address_space(1)))*)cw;
        const float __attribute__((address_space(1)))* const cbp = (const float __attribute__((address_space(1)))*)cb;
        bf16_t __attribute__((address_space(1)))* const actp = (bf16_t __attribute__((address_space(1)))*)ACT;
        float __attribute__((address_space(1)))* const halop = (float __attribute__((address_space(1)))*)HALO;
        const int chl = wc * 32 + 8 * fq;
        PG8_LAS float* const tab = (PG8_LAS float*)(g_lds + HTAB_OFF);
        if (fr >= 14) {
#pragma unroll
            for (int ai = 0; ai < 2; ++ai)
#pragma unroll
                for (int bj = 0; bj < 2; ++bj)
#pragma unroll
                    for (int n = 0; n < 2; ++n) *(PG8_LAS f32x4*)(tab + ((2 * ai + wr) * 2 + (fr - 14)) * 256 + bj * 128 + chl + 4 * n) = acc[ai][bj][3][n];
        }
        asm volatile("s_waitcnt lgkmcnt(0)" ::: "memory"); __builtin_amdgcn_s_barrier(); asm volatile("" ::: "memory");
#pragma unroll
        for (int n = 0; n < 2; ++n) {
            const int ch = u.pn * 128 + chl + 4 * n;
            const f32x4 wg0 = *(const gf4*)(cwp + ch), wg1 = *(const gf4*)(cwp + N2 + ch), wg2 = *(const gf4*)(cwp + 2 * N2 + ch), bg = *(const gf4*)(cbp + ch);
            const f32x4 wu0 = *(const gf4*)(cwp + FF_ + ch), wu1 = *(const gf4*)(cwp + N2 + FF_ + ch), wu2 = *(const gf4*)(cwp + 2 * N2 + FF_ + ch), bu = *(const gf4*)(cbp + FF_ + ch);
#pragma unroll
            for (int ai = 0; ai < 2; ++ai) {
                const int rb = u.pm * BM + ai * HALF + wr * 64;
                const bool hasprev = (ai == 1) || (wr == 1);
                f32x4 pg1 = {0.f, 0.f, 0.f, 0.f}, pg2 = pg1, pu1 = pg1, pu2 = pg1;
                if (hasprev) { const PG8_LAS float* pr = tab + ((2 * ai + wr - 1) * 2) * 256 + chl + 4 * n;
                    const f32x4 g62 = *(const PG8_LAS f32x4*)(pr), g63 = *(const PG8_LAS f32x4*)(pr + 256), u62 = *(const PG8_LAS f32x4*)(pr + 128), u63 = *(const PG8_LAS f32x4*)(pr + 256 + 128);
                    pg1 = g63; pu1 = u63; pg2 = fr == 0 ? g62 : g63; pu2 = fr == 0 ? u62 : u63; }
#pragma unroll
                for (int m = 0; m < 4; ++m) {
                    const f32x4 g = acc[ai][0][m][n], uu = acc[ai][1][m][n];
                    f32x4 rg1, rg2, ru1, ru2;
#pragma unroll
                    for (int j = 0; j < 4; ++j) { rg1[j] = dpp_ror<0x121>(g[j]); rg2[j] = dpp_ror<0x122>(g[j]); ru1[j] = dpp_ror<0x121>(uu[j]); ru2[j] = dpp_ror<0x122>(uu[j]); }
                    const f32x4 hg1 = fr >= 1 ? rg1 : pg1, hg2 = fr >= 2 ? rg2 : pg2, hu1 = fr >= 1 ? ru1 : pu1, hu2 = fr >= 2 ? ru2 : pu2;
                    const f32x4 gc = wg0 * hg2 + wg1 * hg1 + wg2 * g + bg, uc = wu0 * hu2 + wu1 * hu1 + wu2 * uu + bu;
                    f32x4 a;
#pragma unroll
                    for (int j = 0; j < 4; ++j) a[j] = gc[j] * __builtin_amdgcn_rcpf(1.0f + __builtin_amdgcn_exp2f(-1.4426950408889634f * gc[j])) * uc[j];
                    if (m > 0 || fr >= 2 || hasprev) { u32x2 w; w.x = cvt_pk_bf16(a[0], a[1]); w.y = cvt_pk_bf16(a[2], a[3]);
                        *(gu2*)(actp + (unsigned)((rb + m * 16 + fr) * FF_ + ch)) = w; }
                    if (m == 0 && fr < 2 && !hasprev) { float __attribute__((address_space(1)))* hp = halop + (unsigned)(((rb >> 6) * 4 + 2 + fr) * N2 + u.pn * 256 + chl + 4 * n);
                        *(gf4*)hp = g; *(gf4*)(hp + 128) = uu; }
                    if (m == 3 && fr >= 14 && ai == 1 && wr == 1) { float __attribute__((address_space(1)))* hp = halop + (unsigned)(((rb >> 6) * 4 + (fr - 14)) * N2 + u.pn * 256 + chl + 4 * n);
                        *(gf4*)hp = g; *(gf4*)(hp + 128) = uu; }
                    pg1 = rg1; pg2 = rg2; pu1 = ru1; pu2 = ru2;
                }
            }
        }
    }
};
template <class Epi, class Sched, bool ALIGN_EPI = false, bool SP2 = false>
__device__ __forceinline__ void gemm_phase(PG8_LAS unsigned char* lds, const Gemm g, const Sched& S, const Epi& E) {
    const int tid = otid(), wid = __builtin_amdgcn_readfirstlane(tid >> 6), lane = tid & 63, wr = wid >> 2, wc = wid & 3, fr = lane & 15, fq = lane >> 4;
    const int K = g.K, nt = K / BK;
    unsigned voffA[2], voffB[2];
#pragma unroll
    for (int i = 0; i < 2; ++i) { int R, C; stage_rc(tid * 16 + i * 8192, R, C); const int Rb = Epi::PERM ? ((R & ~31) + perm32(R & 31)) : R;
        voffA[i] = (unsigned)(R * K + C) * 2u; voffB[i] = (unsigned)(Rb * K + C) * 2u; }
    const size_t kstep = (size_t)(BK * 2);
    const size_t hstep = (size_t)HALF * K * 2;
    const size_t tstep = 2 * hstep;
    const unsigned ldsw = (unsigned)wid * 1024u;
    const int aoff = lds_byte(wr * 64 + fr, fq * 8), boff = lds_byte(wc * 32 + fr, fq * 8);
#define PG8_SA(b, h) (((b) * 2 + (h)) * HTB)
#define PG8_SB(b, h) ((4 + (b) * 2 + (h)) * HTB)
#define PG8_STAGE(bufoff, gbase, voff) do { _Pragma("unroll") for (int _i = 0; _i < 2; ++_i) \
        __builtin_amdgcn_global_load_lds((const unsigned*)((const char*)(gbase) + (voff)[_i]), (PG8_LAS unsigned*)(lds + (bufoff) + ldsw + _i * 8192), 16, 0, 0); } while (0)
#define PG8_LDA(dst, b, h) do { _Pragma("unroll") for (int m = 0; m < 4; ++m) _Pragma("unroll") for (int k = 0; k < 2; ++k) dst[m][k] = *(const PG8_LAS bf16x8*)(lds + PG8_SA(b, h) + aoff + m * 2048 + k * 1024); } while (0)
#define PG8_LDB(dst, b, h) do { _Pragma("unroll") for (int n = 0; n < 2; ++n) _Pragma("unroll") for (int k = 0; k < 2; ++k) dst[n][k] = *(const PG8_LAS bf16x8*)(lds + PG8_SB(b, h) + boff + n * 2048 + k * 1024); } while (0)
#define PG8_MMA(ai, bj, At, Bt) do { __builtin_amdgcn_s_setprio(1); _Pragma("unroll") for (int m = 0; m < 4; ++m) _Pragma("unroll") for (int n = 0; n < 2; ++n) _Pragma("unroll") for (int k = 0; k < 2; ++k) \
        acc[ai][bj][m][n] = __builtin_amdgcn_mfma_f32_16x16x32_bf16(Bt[n][k], At[m][k], acc[ai][bj][m][n], 0, 0, 0); __builtin_amdgcn_s_setprio(0); } while (0)
#define PG8_WAIT_V(n) asm volatile("s_waitcnt vmcnt(" #n ")" ::: "memory")
#define PG8_WAIT_L(n) asm volatile("s_waitcnt lgkmcnt(" #n ")" ::: "memory")
#define PG8_BAR __builtin_amdgcn_s_barrier()
#define PG8_SCHED __builtin_amdgcn_sched_barrier(0)
    Unit cur, nxt; int ui = 0;
    if (!S.next(0, cur)) return;
    f32x4 acc[2][2][4][2];
#pragma unroll
    for (int a = 0; a < 2; ++a)
#pragma unroll
        for (int b = 0; b < 2; ++b)
#pragma unroll
            for (int m = 0; m < 4; ++m)
#pragma unroll
                for (int n = 0; n < 2; ++n) acc[a][b][m][n] = (f32x4){0.f, 0.f, 0.f, 0.f};
    bf16x8 At[4][2], B0[2][2], B1[2][2];
    const char* cA = (const char*)g.A + (size_t)cur.pm * tstep; const char* cB = (const char*)g.Bt + (size_t)cur.pn * tstep;
    S.a_ready(cur);
    if constexpr (SP2) {
        PG8_STAGE(PG8_SB(0, 0), cB, voffB); PG8_STAGE(PG8_SB(0, 1), cB + hstep, voffB); PG8_STAGE(PG8_SA(0, 0), cA, voffA); PG8_STAGE(PG8_SA(0, 1), cA + hstep, voffA);
        if (wr == 1) PG8_BAR;
        PG8_WAIT_V(2); PG8_BAR;
        PG8_STAGE(PG8_SB(1, 0), cB + kstep, voffB); PG8_STAGE(PG8_SA(1, 0), cA + kstep, voffA); PG8_STAGE(PG8_SB(1, 1), cB + hstep + kstep, voffB);
        PG8_WAIT_V(6); PG8_BAR;
    } else {
        PG8_STAGE(PG8_SB(0, 0), cB, voffB); PG8_STAGE(PG8_SA(0, 0), cA, voffA); PG8_STAGE(PG8_SB(0, 1), cB + hstep, voffB); PG8_STAGE(PG8_SA(0, 1), cA + hstep, voffA);
        if (wr == 1) PG8_BAR;
        PG8_WAIT_V(4); PG8_BAR;
        PG8_STAGE(PG8_SB(1, 0), cB + kstep, voffB); PG8_STAGE(PG8_SA(1, 0), cA + kstep, voffA); PG8_STAGE(PG8_SB(1, 1), cB + hstep + kstep, voffB);
        PG8_WAIT_V(6); PG8_BAR;
    }
    for (;;) {
        const bool has_next = S.next(ui + 1, nxt);
        const char* nA = has_next ? (const char*)g.A + (size_t)nxt.pm * tstep : cA; const char* nB = has_next ? (const char*)g.Bt + (size_t)nxt.pn * tstep : cB;
        for (int t = 0; t < nt; t += 2) {
            const bool last = (t == nt - 2);
            const char* a1 = cA + (size_t)(t + 1) * kstep;
            const char* a2 = last ? nA : cA + (size_t)(t + 2) * kstep; const char* b2 = last ? nB : cB + (size_t)(t + 2) * kstep;
            const char* a3 = a2 + kstep; const char* b3 = b2 + kstep;
            if (last && has_next) S.a_ready(nxt);
            if constexpr (SP2) {
            PG8_LDB(B0, 0, 0); PG8_LDB(B1, 0, 1); PG8_SCHED; PG8_LDA(At, 0, 0); PG8_STAGE(PG8_SA(1, 1), a1 + hstep, voffA);
            PG8_WAIT_V(8); PG8_WAIT_L(0); PG8_BAR; PG8_MMA(0, 0, At, B0); PG8_MMA(0, 1, At, B1); PG8_BAR; PG8_SCHED;
            PG8_LDA(At, 0, 1); PG8_STAGE(PG8_SB(0, 0), b2, voffB); PG8_STAGE(PG8_SB(0, 1), b2 + hstep, voffB); PG8_STAGE(PG8_SA(0, 0), a2, voffA);
            PG8_WAIT_V(8); PG8_WAIT_L(0); PG8_BAR; PG8_MMA(1, 0, At, B0); PG8_MMA(1, 1, At, B1); PG8_BAR; PG8_SCHED;
            PG8_LDB(B0, 1, 0); PG8_LDB(B1, 1, 1); PG8_SCHED; PG8_LDA(At, 1, 0); PG8_STAGE(PG8_SA(0, 1), a2 + hstep, voffA);
            PG8_WAIT_V(8); PG8_WAIT_L(0); PG8_BAR; PG8_MMA(0, 0, At, B0); PG8_MMA(0, 1, At, B1); PG8_BAR; PG8_SCHED;
            PG8_LDA(At, 1, 1); PG8_STAGE(PG8_SB(1, 0), b3, voffB); PG8_STAGE(PG8_SB(1, 1), b3 + hstep, voffB); PG8_STAGE(PG8_SA(1, 0), a3, voffA);
            PG8_WAIT_V(8); PG8_WAIT_L(0); PG8_BAR; PG8_MMA(1, 0, At, B0); PG8_MMA(1, 1, At, B1); PG8_BAR; PG8_SCHED;
            } else {
            PG8_LDB(B0, 0, 0); PG8_SCHED; PG8_LDA(At, 0, 0); PG8_STAGE(PG8_SA(1, 1), a1 + hstep, voffA);
            PG8_WAIT_L(8); PG8_BAR; PG8_WAIT_L(0); PG8_MMA(0, 0, At, B0); PG8_BAR; PG8_SCHED;
            PG8_LDB(B1, 0, 1); PG8_STAGE(PG8_SB(0, 0), b2, voffB);
            PG8_BAR; PG8_WAIT_L(0); PG8_MMA(0, 1, At, B1); PG8_BAR;
            PG8_LDA(At, 0, 1); PG8_STAGE(PG8_SA(0, 0), a2, voffA);
            PG8_BAR; PG8_WAIT_L(0); PG8_MMA(1, 0, At, B0); PG8_BAR; PG8_SCHED;
            PG8_STAGE(PG8_SB(0, 1), b2 + hstep, voffB);
            PG8_WAIT_V(6); PG8_BAR; PG8_MMA(1, 1, At, B1); PG8_BAR;
            PG8_LDB(B0, 1, 0); PG8_SCHED; PG8_LDA(At, 1, 0); PG8_STAGE(PG8_SA(0, 1), a2 + hstep, voffA);
            PG8_WAIT_L(8); PG8_BAR; PG8_WAIT_L(0); PG8_MMA(0, 0, At, B0); PG8_BAR; PG8_SCHED;
            PG8_LDB(B1, 1, 1); PG8_STAGE(PG8_SB(1, 0), b3, voffB);
            PG8_BAR; PG8_WAIT_L(0); PG8_MMA(0, 1, At, B1); PG8_BAR;
            PG8_LDA(At, 1, 1); PG8_STAGE(PG8_SA(1, 0), a3, voffA);
            PG8_BAR; PG8_WAIT_L(0); PG8_MMA(1, 0, At, B0); PG8_BAR; PG8_SCHED;
            PG8_STAGE(PG8_SB(1, 1), b3 + hstep, voffB);
            PG8_WAIT_V(6); PG8_BAR; PG8_MMA(1, 1, At, B1); PG8_BAR;
            }
        }
        if constexpr (ALIGN_EPI) { if (wr == 0) PG8_BAR; }
        if constexpr (!Epi::AFTER_DRAIN) { E(acc, cur, wr, wc, fr, fq); S.done(cur); }
        if (!has_next) break;
#pragma unroll
        for (int a = 0; a < 2; ++a)
#pragma unroll
            for (int b = 0; b < 2; ++b)
#pragma unroll
                for (int m = 0; m < 4; ++m)
#pragma unroll
                    for (int n = 0; n < 2; ++n) acc[a][b][m][n] = (f32x4){0.f, 0.f, 0.f, 0.f};
        cur = nxt; cA = nA; cB = nB; ++ui;
        if constexpr (ALIGN_EPI) { if (wr == 1) PG8_BAR; }
    }
    PG8_WAIT_V(0);
    if constexpr (!ALIGN_EPI) { if (wr == 0) PG8_BAR; }
    PG8_BAR;
    if constexpr (Epi::AFTER_DRAIN) { E.fused(acc, cur, wr, wc, fr, fq, lds, wid, lane); S.done(cur); }
#undef PG8_SA
#undef PG8_SB
#undef PG8_STAGE
#undef PG8_LDA
#undef PG8_LDB
#undef PG8_MMA
#undef PG8_WAIT_V
#undef PG8_WAIT_L
#undef PG8_BAR
#undef PG8_SCHED
}
}

namespace att {
constexpr int D = 128;
constexpr float THR = 8.f;
constexpr bool WSKIP = false;
constexpr int LDQ = 6144, LDKV = 6144, LDO = 2048;
constexpr float SCALE = 0.08838834764831845f;
constexpr int NW = 8, QBLK = 32, KVBLK = 64, QB = NW * QBLK;
constexpr int SHM_V = KVBLK * D * 2, SHM_K = KVBLK * D * 2;
constexpr int LDS_BYTES = 2 * SHM_V + 2 * SHM_K + NW * 64 * 4;

using bf16 = __hip_bfloat16;
typedef short bf16x8 __attribute__((ext_vector_type(8)));
typedef short s16x4 __attribute__((ext_vector_type(4)));
typedef float f32x16 __attribute__((ext_vector_type(16)));
typedef float f32x4 __attribute__((ext_vector_type(4)));
typedef unsigned u32x4 __attribute__((ext_vector_type(4)));
template <class A, class Bt> struct same_t { static constexpr bool v = false; };
template <class A> struct same_t<A, A> { static constexpr bool v = true; };

#define KSWZ(row, colB) ((row) * 256 + ((colB) ^ (((row) & 7) << 4)))
#define SBAR() __builtin_amdgcn_sched_barrier(0)
__device__ __forceinline__ int v_st(int k, int c) { const int kk = (k & ~0xC) | ((k & 4) << 1) | ((k & 8) >> 1); return ((kk >> 3) * 4 + (c >> 5)) * 512 + ((kk & 7) * 32 + (c & 31)) * 2; }
__device__ __forceinline__ int v_rd_base(int lane) { return ((lane & 3) << 3) | (((lane >> 2) & 3) << 6) | (((lane >> 4) & 1) << 5) | (((lane >> 5) & 1) << 8); }
constexpr int v_rd_off(int d0, int ks, int half) { return d0 * 512 + ks * 4096 + half * 2048; }
__device__ __forceinline__ int crow(int r, int hi) { return (r & 3) + 8 * (r >> 2) + 4 * hi; }
__device__ __forceinline__ unsigned cvtpk(float lo, float hi) {
    unsigned r; asm volatile("v_cvt_pk_bf16_f32 %0, %1, %2" : "=v"(r) : "v"(lo), "v"(hi)); return r;
}
__device__ __forceinline__ bf16x8 pack8(f32x4 a, f32x4 b) {
    u32x4 w = {cvtpk(a[0], a[1]), cvtpk(a[2], a[3]), cvtpk(b[0], b[1]), cvtpk(b[2], b[3])};
    return *reinterpret_cast<bf16x8*>(&w);
}
template <class T> __device__ __forceinline__ bf16x8 load8(const T* p) {
    if constexpr (same_t<T, float>::v) { return pack8(*(const f32x4*)p, *(const f32x4*)(p + 4)); }
    else { return *reinterpret_cast<const bf16x8*>(p); }
}
__device__ __forceinline__ void mask_tile(f32x16& p0, f32x16& p1, int dq, unsigned W) {
    const float NEG = -__builtin_inff();
#pragma unroll
    for (int r = 0; r < 16; ++r) {
        const int c = (r & 3) + 8 * (r >> 2);
        if ((unsigned)(dq - c) >= W) p0[r] = NEG;
        if ((unsigned)(dq - c - 32) >= W) p1[r] = NEG;
    }
}
__device__ __forceinline__ void partialSM(f32x16& p0, f32x16& p1, float& m_reg, float& mn, float& alpha) {
    float pmax = p0[0]; for (int r = 1; r < 16; ++r) pmax = fmaxf(pmax, p0[r]); for (int r = 0; r < 16; ++r) pmax = fmaxf(pmax, p1[r]);
    { auto rr = __builtin_amdgcn_permlane32_swap(__float_as_uint(pmax), __float_as_uint(pmax), false, false);
      pmax = fmaxf(__uint_as_float(rr[0]), __uint_as_float(rr[1])); }
    constexpr float C2 = 1.4426950408889634f * SCALE;
    if (__builtin_expect(__all((pmax - m_reg) * SCALE <= THR), 1)) { mn = m_reg; alpha = 1.f; }
    else { mn = fmaxf(m_reg, pmax); alpha = __builtin_amdgcn_exp2f((m_reg - mn) * C2); m_reg = mn; }
    const float mnL = -mn * C2;
    for (int r = 0; r < 16; ++r) p0[r] = fmaf(p0[r], C2, mnL); for (int r = 0; r < 16; ++r) p1[r] = fmaf(p1[r], C2, mnL);
    for (int r = 0; r < 16; ++r) p0[r] = __builtin_amdgcn_exp2f(p0[r]);
}
__device__ __forceinline__ void finishSM(f32x16& p0, f32x16& p1, float alpha, float& l_reg, bf16x8& pa0, bf16x8& pa1, bf16x8& pa2, bf16x8& pa3) {
    for (int r = 0; r < 16; ++r) p1[r] = __builtin_amdgcn_exp2f(p1[r]);
    float ps = 0; for (int r = 0; r < 16; ++r) ps += p0[r]; for (int r = 0; r < 16; ++r) ps += p1[r];
    { auto rr = __builtin_amdgcn_permlane32_swap(__float_as_uint(ps), __float_as_uint(ps), false, false);
      ps = __uint_as_float(rr[0]) + __uint_as_float(rr[1]); }
    l_reg = l_reg * alpha + ps;
#define PK4(P, B_, OUT) do { unsigned a0 = cvtpk(P[B_+0], P[B_+1]), a1 = cvtpk(P[B_+2], P[B_+3]);                          \
        unsigned b0 = cvtpk(P[B_+4], P[B_+5]), b1 = cvtpk(P[B_+6], P[B_+7]);                                             \
        auto r0 = __builtin_amdgcn_permlane32_swap(a0, b0, false, false); auto r1 = __builtin_amdgcn_permlane32_swap(a1, b1, false, false); \
        u32x4 w = {r0[0], r1[0], r0[1], r1[1]}; OUT = *reinterpret_cast<bf16x8*>(&w); } while (0)
    PK4(p0, 0, pa0); PK4(p0, 8, pa1); PK4(p1, 0, pa2); PK4(p1, 8, pa3);
#undef PK4
}
template <int KB, bool SK>
__device__ __forceinline__ void qkt(f32x16& p0, f32x16& p1, const char* K_lds, int r32, int hi, const bf16x8* qr, bool act) {
    if (SK && !act) { const float NEG = -__builtin_inff();
#pragma unroll
        for (int r = 0; r < 16; ++r) { p0[r] = NEG; p1[r] = NEG; } return; }
    p0 = f32x16{}; p1 = f32x16{};
    const char* kb[4];
#pragma unroll
    for (int dd = 0; dd < 4; ++dd) kb[dd] = K_lds + KB * SHM_K + KSWZ(r32, (dd * 16 + hi * 8) * 2);
#pragma unroll
    for (int d0 = 0; d0 < 8; ++d0) { const char* a = kb[d0 & 3] + (d0 >> 2) * 128;
        bf16x8 b0 = *reinterpret_cast<const bf16x8*>(a);
        bf16x8 b1 = *reinterpret_cast<const bf16x8*>(a + 32 * 256);
        p0 = __builtin_amdgcn_mfma_f32_32x32x16_bf16(b0, qr[d0], p0, 0, 0, 0);
        p1 = __builtin_amdgcn_mfma_f32_32x32x16_bf16(b1, qr[d0], p1, 0, 0, 0); }
}
template <int VB, bool SK>
__device__ __forceinline__ void pv_tile(f32x16* o, int vb0, bf16x8 pa0, bf16x8 pa1, bf16x8 pa2, bf16x8 pa3, bool act) {
    if (SK && !act) return;
#define TRRD(dst, off) asm volatile("ds_read_b64_tr_b16 %0, %1 offset:%2" : "=&v"(dst) : "v"(vb0), "i"(off) : "memory")
#define PV_D0(d0) do { s16x4 l0, l1, l2, l3, h0, h1, h2, h3; constexpr int b_ = VB * SHM_V + v_rd_off(d0, 0, 0);     \
        TRRD(l0, b_); TRRD(h0, b_ + 2048); TRRD(l1, b_ + 4096); TRRD(h1, b_ + 6144); TRRD(l2, b_ + 8192); TRRD(h2, b_ + 10240); TRRD(l3, b_ + 12288); TRRD(h3, b_ + 14336); \
        asm volatile("s_waitcnt lgkmcnt(0)" ::: "memory"); SBAR();                 \
        o[d0] = __builtin_amdgcn_mfma_f32_32x32x16_bf16(pa0, (bf16x8){l0[0], l0[1], l0[2], l0[3], h0[0], h0[1], h0[2], h0[3]}, o[d0], 0, 0, 0);   \
        o[d0] = __builtin_amdgcn_mfma_f32_32x32x16_bf16(pa1, (bf16x8){l1[0], l1[1], l1[2], l1[3], h1[0], h1[1], h1[2], h1[3]}, o[d0], 0, 0, 0);   \
        o[d0] = __builtin_amdgcn_mfma_f32_32x32x16_bf16(pa2, (bf16x8){l2[0], l2[1], l2[2], l2[3], h2[0], h2[1], h2[2], h2[3]}, o[d0], 0, 0, 0);   \
        o[d0] = __builtin_amdgcn_mfma_f32_32x32x16_bf16(pa3, (bf16x8){l3[0], l3[1], l3[2], l3[3], h3[0], h3[1], h3[2], h3[3]}, o[d0], 0, 0, 0); } while (0)
    PV_D0(0); PV_D0(1); PV_D0(2); PV_D0(3);
#undef PV_D0
#undef TRRD
}

template <class TIn, class TOut> struct BlockRef { const TIn* Q; const TIn* K; const TIn* V; TOut* O; int P0; };
template <class TIn> struct Seam {
    bf16x8 qr[8];
    bf16x8 st_v0, st_v1, st_k0, st_k1; f32x4 sf0, sf1, sf2, sf3;
    f32x4 tq[16];
};
__device__ __forceinline__ int swa_jlo(int P0, int W) { const int lowk = P0 - W + 1; return lowk > 0 ? lowk / KVBLK : 0; }
#define ROW(p, k0, rr) ((p) + (size_t)((k0) + (rr)) * LDKV + sc)
#define VMW() asm volatile("s_waitcnt vmcnt(0)" ::: "memory")
#define VMWN(n) asm volatile("s_waitcnt vmcnt(%0)" :: "i"(n) : "memory")
#define SLOAD_H(Kp, Vp, k0) do { S.st_v0 = load8<TIn>(ROW(Vp, k0, sr)); S.st_v1 = load8<TIn>(ROW(Vp, k0, 32 + sr));              \
                         S.st_k0 = load8<TIn>(ROW(Kp, k0, sr)); S.st_k1 = load8<TIn>(ROW(Kp, k0, 32 + sr)); } while (0)
#define SWRITE_HK(bf) do { *(bf16x8*)(K_lds + (bf) * SHM_K + kws) = S.st_k0; *(bf16x8*)(K_lds + (bf) * SHM_K + kws + 32 * 256) = S.st_k1; } while (0)
#define SWRITE_HV(bf) do { *(bf16x8*)(V_lds + (bf) * SHM_V + vst0) = S.st_v0; *(bf16x8*)(V_lds + (bf) * SHM_V + vst1) = S.st_v1; } while (0)
#define SWRITE_H(bf) do { SWRITE_HV(bf); SWRITE_HK(bf); } while (0)
#define SLOAD_F(p, k0) do { S.sf0 = *(const f32x4*)ROW(p, k0, sr); S.sf1 = *(const f32x4*)(ROW(p, k0, sr) + 4);                \
                            S.sf2 = *(const f32x4*)ROW(p, k0, 32 + sr); S.sf3 = *(const f32x4*)(ROW(p, k0, 32 + sr) + 4); } while (0)
#define SWRITE_KF(bf) do { *(bf16x8*)(K_lds + (bf) * SHM_K + kws) = pack8(S.sf0, S.sf1); *(bf16x8*)(K_lds + (bf) * SHM_K + kws + 32 * 256) = pack8(S.sf2, S.sf3); } while (0)
#define SWRITE_VF(bf) do { *(bf16x8*)(V_lds + (bf) * SHM_V + vst0) = pack8(S.sf0, S.sf1); *(bf16x8*)(V_lds + (bf) * SHM_V + vst1) = pack8(S.sf2, S.sf3); } while (0)
template <class TIn, class TOut>
__device__ __forceinline__ void causal_swa_prime(const BlockRef<TIn, TOut>& cur, int W, char* lds, Seam<TIn>& S) {
    constexpr bool F32 = same_t<TIn, float>::v;
    const int tid = otid(), wid = __builtin_amdgcn_readfirstlane(tid >> 6), lane = tid & 63, r32 = lane & 31, hi = lane >> 5;
    const int sr = tid >> 4, sc = (tid & 15) * 8, kws = KSWZ(sr, sc * 2); char* K_lds = lds + 2 * SHM_V;
    const int kb0 = swa_jlo(cur.P0, W) * KVBLK;
    for (int d0 = 0; d0 < 8; ++d0) S.qr[d0] = load8<TIn>(cur.Q + (size_t)(wid * QBLK + r32) * LDQ + d0 * 16 + hi * 8);
    if constexpr (F32) { SLOAD_F((const float*)cur.K, kb0); VMW(); SWRITE_KF(0); SBAR(); SLOAD_F((const float*)cur.V, kb0); }
    else { SLOAD_H(cur.K, cur.V, kb0); VMW(); SWRITE_HK(0); }
    __syncthreads();
}
template <class TIn, class TOut>
__device__ __forceinline__ void causal_swa_block(const BlockRef<TIn, TOut>& cur, const BlockRef<TIn, TOut>& nxt, int skv, int W, char* lds, Seam<TIn>& S) {
    constexpr bool F32 = same_t<TIn, float>::v;
    const int tid = otid(), wid = __builtin_amdgcn_readfirstlane(tid >> 6), lane = tid & 63, r32 = lane & 31, hi = lane >> 5;
    const int j_lo = swa_jlo(cur.P0, W);
    int j_hi = (cur.P0 + QB - 1) / KVBLK + 1; if (j_hi > skv / KVBLK) j_hi = skv / KVBLK;
    const int NT = j_hi - j_lo;
    const int kbn = swa_jlo(nxt.P0, W) * KVBLK;
    const int qlo = cur.P0 + wid * QBLK, qm = qlo + r32 - 4 * hi;
    char* V_lds = lds; char* K_lds = lds + 2 * SHM_V;
    float* ws = (float*)(lds + 2 * SHM_V + 2 * SHM_K) + wid * 64; float* li_l = ws, * al_l = ws + 32;
    float m_reg = -1e30f, l_reg = 0; f32x16 o[4] = {};
    const int sr = tid >> 4, sc = (tid & 15) * 8, vst0 = v_st(sr, sc), vst1 = v_st(32 + sr, sc), kws = KSWZ(sr, sc * 2);
    const int vb0 = (int)(uintptr_t)V_lds + v_rd_base(lane);
    const TIn* Kh = cur.K; const TIn* Vh = cur.V;
#define RESC(a) do { if (__any((a) < 1.f)) { if (hi == 0) al_l[r32] = (a); asm volatile("s_waitcnt lgkmcnt(0)" ::: "memory");              \
                     for (int d_ = 0; d_ < 4; ++d_) for (int r = 0; r < 16; ++r) o[d_][r] *= al_l[crow(r, hi)]; } } while (0)
#define KBASE(t) ((j_lo + (t)) * KVBLK)
#define ACT(t) (KBASE(t) <= qlo + QBLK - 1 && KBASE(t) + KVBLK - 1 >= qlo - W + 1)
#define MASKT(P0_, P1_, t) do { const int kb_ = KBASE(t); if ((!SK || ACT(t)) && (kb_ + KVBLK - 1 > qlo || kb_ <= qlo + QBLK - 1 - W)) mask_tile(P0_, P1_, qm - kb_, (unsigned)W); } while (0)
    constexpr int NQL = F32 ? 16 : 8;
    constexpr bool SK = WSKIP && !F32;
#define SEAM_K0() do { VMWN(NQL); if constexpr (F32) { SWRITE_KF(0); SBAR(); SLOAD_F((const float*)nxt.V, kbn); } else { SWRITE_HK(0); } SBAR(); } while (0)
    f32x16 pA0, pA1, pB0, pB1; float mnA, mnB, alA, alB; bf16x8 pa0, pa1, pa2, pa3;
    if constexpr (F32) { VMW(); SWRITE_VF(0); SBAR(); } else { SWRITE_HV(0); SBAR(); }
    if (NT > 1) { if constexpr (F32) SLOAD_F((const float*)Kh, KBASE(1)); else SLOAD_H(Kh, Vh, KBASE(1)); }
    SBAR(); qkt<0, SK>(pA0, pA1, K_lds, r32, hi, S.qr, ACT(0));
    if constexpr (F32) { if (NT > 1) { VMW(); SWRITE_KF(1); SBAR(); SLOAD_F((const float*)Vh, KBASE(1)); } }
    MASKT(pA0, pA1, 0); partialSM(pA0, pA1, m_reg, mnA, alA);
    if (NT > 1) { VMW(); if constexpr (F32) { SWRITE_VF(1); SBAR(); if (NT > 2) SLOAD_F((const float*)Kh, KBASE(2)); } else SWRITE_H(1); }
    __syncthreads();
#define HALF_STEP(PX0, PX1, mnX, alX, PY0, PY1, alY, t, KB, VB, SB) do {                                                      \
        SBAR(); qkt<KB, SK>(PX0, PX1, K_lds, r32, hi, S.qr, ACT(t));                                             \
        finishSM(PY0, PY1, alY, l_reg, pa0, pa1, pa2, pa3); SBAR();                                                           \
        if ((t) + 1 < NT) { if constexpr (F32) { VMW(); SWRITE_KF(SB); SBAR(); SLOAD_F((const float*)Vh, KBASE((t) + 1)); }  \
                            else { SLOAD_H(Kh, Vh, KBASE((t) + 1)); } SBAR(); }                                               \
        pv_tile<VB, SK>(o, vb0, pa0, pa1, pa2, pa3, ACT((t) - 1)); MASKT(PX0, PX1, (t)); partialSM(PX0, PX1, m_reg, mnX, alX);                                        \
        __syncthreads();                                                                                                      \
        if ((t) + 1 < NT) { VMW(); if constexpr (F32) { SWRITE_VF(SB); SBAR(); if ((t) + 2 < NT) SLOAD_F((const float*)Kh, KBASE((t) + 2)); } \
                            else { SWRITE_H(SB); } }                                                                          \
        RESC(alX); __syncthreads(); } while (0)
    for (int t = 1; t + 1 < NT; t += 2) {
        HALF_STEP(pB0, pB1, mnB, alB, pA0, pA1, alA, t, 1, 0, 0);
        HALF_STEP(pA0, pA1, mnA, alA, pB0, pB1, alB, t + 1, 0, 1, 1);
    }
    const bool even = (NT & 1) == 0;
    if (even) { SBAR(); qkt<1, SK>(pB0, pB1, K_lds, r32, hi, S.qr, ACT(NT - 1)); SBAR(); }
#define QROW(e) (nxt.Q + (size_t)(wid * QBLK + r32) * LDQ + ((e) >> 1) * 16 + hi * 8 + ((e) & 1) * 4)
    if constexpr (F32) { SLOAD_F((const float*)nxt.K, kbn); SBAR();
#pragma unroll
        for (int e = 0; e < 8; ++e) S.tq[e] = *(const f32x4*)QROW(e); }
    else { SLOAD_H(nxt.K, nxt.V, kbn); SBAR();
#pragma unroll
        for (int d0 = 0; d0 < 8; ++d0) S.qr[d0] = load8<TIn>(nxt.Q + (size_t)(wid * QBLK + r32) * LDQ + d0 * 16 + hi * 8); }
    SBAR();
    finishSM(pA0, pA1, alA, l_reg, pa0, pa1, pa2, pa3); SBAR();
    if constexpr (F32) {
#pragma unroll
        for (int e = 8; e < 16; ++e) S.tq[e] = *(const f32x4*)QROW(e); SBAR(); }
#undef QROW
    pv_tile<0, SK>(o, vb0, pa0, pa1, pa2, pa3, ACT(even ? NT - 2 : NT - 1));
    if (even) { MASKT(pB0, pB1, NT - 1); partialSM(pB0, pB1, m_reg, mnB, alB); __syncthreads(); RESC(alB);
        finishSM(pB0, pB1, alB, l_reg, pa0, pa1, pa2, pa3); SBAR(); pv_tile<1, SK>(o, vb0, pa0, pa1, pa2, pa3, ACT(NT - 1)); }
    SBAR(); SEAM_K0();
    if (hi == 0) li_l[r32] = l_reg; asm volatile("s_waitcnt lgkmcnt(0)" ::: "memory");
    float rli[16];
#pragma unroll
    for (int r = 0; r < 16; ++r) rli[r] = __builtin_amdgcn_rcpf(li_l[crow(r, hi)]);
    TOut* Ow = cur.O + (size_t)(wid * QBLK) * LDO;
#pragma unroll
    for (int r = 0; r < 16; ++r) { const int orow = crow(r, hi);
#pragma unroll
        for (int d0 = 0; d0 < 4; ++d0) { const float v = o[d0][r] * rli[r];
            if constexpr (same_t<TOut, float>::v) { Ow[(size_t)orow * LDO + d0 * 32 + r32] = v; }
            else { const float vn = swz_xor<1>(v, lane);
                   if ((r32 & 1) == 0) *(unsigned*)(Ow + (size_t)orow * LDO + d0 * 32 + r32) = cvtpk(v, vn); } } }
    if constexpr (F32) {
#pragma unroll
        for (int d0 = 0; d0 < 8; ++d0) S.qr[d0] = pack8(S.tq[2 * d0], S.tq[2 * d0 + 1]); }
    __syncthreads();
#undef RESC
#undef KBASE
#undef ACT
#undef MASKT
#undef SEAM_K0
#undef HALF_STEP
}
#undef ROW
#undef VMW
#undef VMWN
#undef SLOAD_H
#undef SWRITE_HK
#undef SWRITE_HV
#undef SWRITE_H
#undef SLOAD_F
#undef SWRITE_KF
#undef SWRITE_VF

}

typedef unsigned short bf16_t;
typedef float f32x4 __attribute__((ext_vector_type(4)));
typedef unsigned u32x4 __attribute__((ext_vector_type(4)));
typedef unsigned u32x2 __attribute__((ext_vector_type(2)));
#define LAS __attribute__((address_space(3)))

constexpr int T_ = 16384, DM = 2048, FF = 5632, SEQ = 4096, N6 = 6144, NUP = 2 * FF;
constexpr float ALPHA = 1.4142135623730951f;
constexpr float LN_EPS = 1e-5f, SUBLN_EPS = 1e-5f;
constexpr float LAMBDA_INIT = 0.35550906759309685f;
constexpr int NTHREADS = 512, LDS_STAGE = 131072, LDS_BYTES = LDS_STAGE + 16 + 256 + 8192;

constexpr size_t SZ_WIN = (size_t)N6 * DM * 2, SZ_WSQ = (size_t)DM * DM * 2, SZ_WUP = (size_t)NUP * DM * 2, SZ_WDN = (size_t)DM * FF * 2;
constexpr size_t OFF_WIN = 0, OFF_WOUT = OFF_WIN + SZ_WIN, OFF_WUP0 = OFF_WOUT + SZ_WSQ, OFF_WDN0 = OFF_WUP0 + SZ_WUP;
constexpr size_t OFF_WQKV = OFF_WDN0 + SZ_WDN, OFF_WO = OFF_WQKV + SZ_WIN, OFF_WUP1 = OFF_WO + SZ_WSQ, OFF_WDN1 = OFF_WUP1 + SZ_WUP;
constexpr size_t OFF_Z = OFF_WDN1 + SZ_WDN, OFF_XB = OFF_Z + (size_t)T_ * DM * 4, OFF_R = OFF_XB + (size_t)T_ * DM * 2;
constexpr size_t SZ_R = (size_t)T_ * 8192 * 2, OFF_ROPE = OFF_R + SZ_R, OFF_BAR = OFF_ROPE + (size_t)T_ * 16 * 4 * 2, OFF_LNST = OFF_BAR + 16384, WS_END = OFF_LNST + 3 * (size_t)T_ * 2 * 4;
#define LNST(i) ((float*)(ws + OFF_LNST) + (size_t)(i) * 2 * T_)
constexpr size_t R_BIG = 0, R_SMALL = (size_t)T_ * N6 * 2;
constexpr size_t R_ACT = 0, R_HALO = (size_t)T_ * FF * 2;
static_assert(R_HALO + (size_t)(T_ / 64) * 4 * NUP * 4 <= SZ_R, "halo fits");

struct Params {
    const float* x; const int* pos; const float* ln_g; const float* ln_b; const float* a_w_in; const float* a_conv_w; const float* a_w_out;
    const float* w_k; const float* w_v; const float* w_q; const float* lam; const float* subln_g; const float* w_o;
    const float* w_up; const float* ffn_cw; const float* ffn_cb; const float* w_dn;
    float* out; unsigned char* ws;
};

__device__ __forceinline__ unsigned pk2(float lo, float hi) { return pg8::cvt_pk_bf16(lo, hi); }
__device__ __forceinline__ float bf_lo(unsigned w) { return __uint_as_float(w << 16); }
__device__ __forceinline__ float bf_hi(unsigned w) { return __uint_as_float(w & 0xffff0000u); }
__device__ __forceinline__ float wave_sum(float v, int lane) {
    return wsum64(v, lane);
}
#define LDS_WAIT() asm volatile("s_waitcnt lgkmcnt(0)" ::: "memory")

struct TItem { const float* W; bf16_t* WT; int K, N, mode, row_off, item; };
__device__ __forceinline__ void titem_load(const TItem& t, int lane, f32x4 (&v)[8]) {
    const int nblk = t.N / 32, kb = t.item / nblk, nb = t.item - kb * nblk, k0 = 64 * kb, n0 = 32 * nb, c4 = (lane & 7) * 4;
#pragma unroll
    for (int i = 0; i < 8; ++i) v[i] = *(const f32x4*)(t.W + (size_t)(k0 + 8 * i + (lane >> 3)) * t.N + n0 + c4);
}
__device__ __forceinline__ void titem_store(const TItem& t, int lane, const f32x4 (&v)[8], LAS float* scr) {
    const int K = t.K, nblk = t.N / 32, kb = t.item / nblk, nb = t.item - kb * nblk, k0 = 64 * kb, n0 = 32 * nb, c4 = (lane & 7) * 4;
#pragma unroll
    for (int i = 0; i < 8; ++i) { const int kk = 8 * i + (lane >> 3);
        scr[kk * 33 + c4 + 0] = v[i][0]; scr[kk * 33 + c4 + 1] = v[i][1]; scr[kk * 33 + c4 + 2] = v[i][2]; scr[kk * 33 + c4 + 3] = v[i][3]; }
    LDS_WAIT();
    int drow0;
    if (t.mode == 0) drow0 = t.row_off + n0;
    else if (t.mode == 1) { const int isu = n0 >= FF, c = isu ? n0 - FF : n0; drow0 = (c >> 7) * 256 + (isu ? 128 : 0) + (c & 127); }
    else { if (n0 < DM) drow0 = 2 * DM + n0;
           else { const int isv = n0 >= 2 * DM, c = n0 - (isv ? 2 * DM : DM); drow0 = (c >> 7) * 256 + (isv ? 128 : 0) + (c & 127); } }
    const int c = lane & 7;
#pragma unroll
    for (int j = 0; j < 4; ++j) { const int n = (lane >> 3) + 8 * j; const LAS float* s = scr + (8 * c) * 33 + n;
        u32x4 o; o.x = pk2(s[0 * 33], s[1 * 33]); o.y = pk2(s[2 * 33], s[3 * 33]); o.z = pk2(s[4 * 33], s[5 * 33]); o.w = pk2(s[6 * 33], s[7 * 33]);
        *(u32x4*)(t.WT + (size_t)(drow0 + n) * K + k0 + 8 * c) = o; }
    LDS_WAIT();
}
__device__ __forceinline__ TItem titem_decode(const Params& p, unsigned char* ws, int it) {
    constexpr int I_IN = (DM / 64) * (N6 / 32), I_SQ = (DM / 64) * (DM / 32), I_UP = (DM / 64) * (NUP / 32), I_DN = (FF / 64) * (DM / 32);
    int r = it;
    if (r < I_IN) return TItem{p.a_w_in, (bf16_t*)(ws + OFF_WIN), DM, N6, 2, 0, r}; r -= I_IN;
    if (r < I_SQ) return TItem{p.a_w_out, (bf16_t*)(ws + OFF_WOUT), DM, DM, 0, 0, r}; r -= I_SQ;
    if (r < I_SQ) return TItem{p.w_q, (bf16_t*)(ws + OFF_WQKV), DM, DM, 0, 0, r}; r -= I_SQ;
    if (r < I_SQ) return TItem{p.w_k, (bf16_t*)(ws + OFF_WQKV), DM, DM, 0, DM, r}; r -= I_SQ;
    if (r < I_SQ) return TItem{p.w_v, (bf16_t*)(ws + OFF_WQKV), DM, DM, 0, 2 * DM, r}; r -= I_SQ;
    if (r < I_SQ) return TItem{p.w_o, (bf16_t*)(ws + OFF_WO), DM, DM, 0, 0, r}; r -= I_SQ;
    if (r < I_UP) return TItem{p.w_up, (bf16_t*)(ws + OFF_WUP0), DM, NUP, 1, 0, r}; r -= I_UP;
    if (r < I_UP) return TItem{p.w_up + (size_t)DM * NUP, (bf16_t*)(ws + OFF_WUP1), DM, NUP, 1, 0, r}; r -= I_UP;
    if (r < I_DN) return TItem{p.w_dn, (bf16_t*)(ws + OFF_WDN0), FF, DM, 0, 0, r}; r -= I_DN;
    return TItem{p.w_dn + (size_t)FF * DM, (bf16_t*)(ws + OFF_WDN1), FF, DM, 0, 0, r};
}
__device__ __forceinline__ void phase_prologue(const Params& p, LAS unsigned char* lds) {
    const int tid = otid(), lane = tid & 63, wave = tid >> 6;
    const int gw = blockIdx.x * 8 + wave, NGW = gridDim.x * 8;
    LAS float* scr = (LAS float*)(lds + wave * 16384);
    unsigned char* ws = p.ws;
    constexpr int NITEMS = (DM / 64) * (N6 / 32) + 5 * (DM / 64) * (DM / 32) + 2 * (DM / 64) * (NUP / 32) + 2 * (FF / 64) * (DM / 32);
    {
        int it = gw;
        f32x4 vc[8], vn[8];
        if (it < NITEMS) { const TItem t = titem_decode(p, ws, it); titem_load(t, lane, vc); }
        while (it < NITEMS) {
            const int itn = it + NGW;
            if (itn < NITEMS) { const TItem tn = titem_decode(p, ws, itn); titem_load(tn, lane, vn); }
            { const TItem t = titem_decode(p, ws, it); titem_store(t, lane, vc, scr); }
#pragma unroll
            for (int i = 0; i < 8; ++i) vc[i] = vn[i];
            it = itn;
        }
    }
    const int gt = blockIdx.x * NTHREADS + tid, NGT = gridDim.x * NTHREADS;
    bf16_t* XB = (bf16_t*)(ws + OFF_XB);
    for (int i = gt; i < T_ * DM / 8; i += 4 * NGT) {
        f32x4 a[4], b[4];
#pragma unroll
        for (int q = 0; q < 4; ++q) { const int ii = i + q * NGT; if (ii < T_ * DM / 8) { a[q] = *(const f32x4*)(p.x + (size_t)ii * 8); b[q] = *(const f32x4*)(p.x + (size_t)ii * 8 + 4); } }
#pragma unroll
        for (int q = 0; q < 4; ++q) { const int ii = i + q * NGT; if (ii < T_ * DM / 8) {
            u32x4 o; o.x = pk2(a[q][0], a[q][1]); o.y = pk2(a[q][2], a[q][3]); o.z = pk2(b[q][0], b[q][1]); o.w = pk2(b[q][2], b[q][3]); *(u32x4*)(XB + (size_t)ii * 8) = o; } } }
    float* COS = (float*)(ws + OFF_ROPE); float* SIN = COS + T_ * 16;
    for (int i = gt; i < T_ * 16; i += NGT) { const int t = i >> 4, k = i & 15; const float ang = (float)p.pos[t] * __builtin_amdgcn_exp2f(-1.1832230355827609f * (float)k);
        double rev = (double)ang * 0.15915494309189535; rev -= floor(rev); const float fr = (float)rev;
        COS[i] = __builtin_amdgcn_cosf(fr); SIN[i] = __builtin_amdgcn_sinf(fr); }
}

__device__ __forceinline__ void unpack8(const u32x4 w, float (&f)[8]) {
    f[0] = bf_lo(w.x); f[1] = bf_hi(w.x); f[2] = bf_lo(w.y); f[3] = bf_hi(w.y); f[4] = bf_lo(w.z); f[5] = bf_hi(w.z); f[6] = bf_lo(w.w); f[7] = bf_hi(w.w);
}
__device__ __forceinline__ void phase_mixer(const Params& p) {
    const bf16_t* Bq = (const bf16_t*)(p.ws + OFF_R + R_BIG); const bf16_t* CV = Bq + (size_t)T_ * DM; bf16_t* Y = (bf16_t*)(p.ws + OFF_R + R_SMALL);
    const int gt = blockIdx.x * NTHREADS + otid(), NGT = gridDim.x * NTHREADS;
    for (int id = gt; id < (T_ / 16) * 256; id += NGT) {
        const int cgp = id & 255, t0 = (id >> 8) * 16, ch = cgp * 8;
        float w0[8], w1[8], w2[8];
        { const f32x4 a = *(const f32x4*)(p.a_conv_w + ch), b = *(const f32x4*)(p.a_conv_w + ch + 4);
          w0[0] = a[0]; w0[1] = a[1]; w0[2] = a[2]; w0[3] = a[3]; w0[4] = b[0]; w0[5] = b[1]; w0[6] = b[2]; w0[7] = b[3]; }
        { const f32x4 a = *(const f32x4*)(p.a_conv_w + DM + ch), b = *(const f32x4*)(p.a_conv_w + DM + ch + 4);
          w1[0] = a[0]; w1[1] = a[1]; w1[2] = a[2]; w1[3] = a[3]; w1[4] = b[0]; w1[5] = b[1]; w1[6] = b[2]; w1[7] = b[3]; }
        { const f32x4 a = *(const f32x4*)(p.a_conv_w + 2 * DM + ch), b = *(const f32x4*)(p.a_conv_w + 2 * DM + ch + 4);
          w2[0] = a[0]; w2[1] = a[1]; w2[2] = a[2]; w2[3] = a[3]; w2[4] = b[0]; w2[5] = b[1]; w2[6] = b[2]; w2[7] = b[3]; }
        float m2[8], m1[8];
        if ((t0 & (SEQ - 1)) == 0) {
#pragma unroll
            for (int k = 0; k < 8; ++k) { m2[k] = 0.f; m1[k] = 0.f; }
        } else {
            unpack8(*(const u32x4*)(CV + (size_t)(t0 - 2) * DM + ch), m2); unpack8(*(const u32x4*)(CV + (size_t)(t0 - 1) * DM + ch), m1);
        }
#pragma unroll 4
        for (int r = 0; r < 16; ++r) {
            const size_t ro = (size_t)(t0 + r) * DM + ch;
            float b[8], cvv[8], y[8];
            unpack8(*(const u32x4*)(Bq + ro), b); unpack8(*(const u32x4*)(CV + ro), cvv);
#pragma unroll
            for (int k = 0; k < 8; ++k) { const float cv = cvv[k]; y[k] = b[k] * (w0[k] * m2[k] + w1[k] * m1[k] + w2[k] * cv); m2[k] = m1[k]; m1[k] = cv; }
            u32x4 o; o.x = pk2(y[0], y[1]); o.y = pk2(y[2], y[3]); o.z = pk2(y[4], y[5]); o.w = pk2(y[6], y[7]);
            *(u32x4*)(Y + (size_t)(t0 + r) * DM + ch) = o;
        }
    }
}

__device__ __forceinline__ void phase_ln(const float* Z, float* OUT, bf16_t* XB, const float* g, const float* b, float* ST) {
    constexpr int RPI = 4;
    const int lane = otid() & 63, gw = blockIdx.x * 8 + (otid() >> 6), NGW = gridDim.x * 8;
    for (int row0 = gw * RPI; row0 < T_; row0 += NGW * RPI) {
        f32x4 v[RPI][8]; float s[RPI], s2[RPI];
#pragma unroll
        for (int r = 0; r < RPI; ++r) { const f32x4* zr = (const f32x4*)(Z + (size_t)(row0 + r) * DM) + lane;
#pragma unroll
            for (int j = 0; j < 8; ++j) v[r][j] = zr[64 * j]; }
#pragma unroll
        for (int r = 0; r < RPI; ++r) { s[r] = 0.f;
#pragma unroll
            for (int j = 0; j < 8; ++j) s[r] += (v[r][j][0] + v[r][j][1]) + (v[r][j][2] + v[r][j][3]); }
#pragma unroll
        for (int r = 0; r < RPI; ++r) s[r] = wsum64(s[r], lane);
#pragma unroll
        for (int r = 0; r < RPI; ++r) { const float mean = s[r] * (1.f / DM); s[r] = mean; s2[r] = 0.f;
#pragma unroll
            for (int j = 0; j < 8; ++j) { v[r][j] = v[r][j] - mean; s2[r] += (v[r][j][0] * v[r][j][0] + v[r][j][1] * v[r][j][1]) + (v[r][j][2] * v[r][j][2] + v[r][j][3] * v[r][j][3]); } }
#pragma unroll
        for (int r = 0; r < RPI; ++r) s2[r] = wsum64(s2[r], lane);
        if (ST && lane == 0) {
#pragma unroll
            for (int r = 0; r < RPI; ++r) { ST[2 * (size_t)(row0 + r)] = s[r]; ST[2 * (size_t)(row0 + r) + 1] = 1.f / sqrtf(s2[r] * (1.f / DM) + LN_EPS); } }
#pragma unroll
        for (int j = 0; j < 8; ++j) { const f32x4 gg = ((const f32x4*)g)[lane + 64 * j], bb = ((const f32x4*)b)[lane + 64 * j];
#pragma unroll
            for (int r = 0; r < RPI; ++r) { const float rstd = 1.f / sqrtf(s2[r] * (1.f / DM) + LN_EPS);
                const f32x4 o = v[r][j] * rstd * gg + bb;
                if (OUT) ((f32x4*)(OUT + (size_t)(row0 + r) * DM) + lane)[64 * j] = o;
                if (XB) { u32x2 w; w.x = pk2(o[0], o[1]); w.y = pk2(o[2], o[3]); ((u32x2*)(XB + (size_t)(row0 + r) * DM) + lane)[64 * j] = w; } } }
    }
}

__device__ __forceinline__ f32x4 silu_mul(f32x4 gc, f32x4 uc) {
    f32x4 a;
#pragma unroll
    for (int j = 0; j < 4; ++j) a[j] = gc[j] * __builtin_amdgcn_rcpf(1.0f + __builtin_amdgcn_exp2f(-1.4426950408889634f * gc[j])) * uc[j];
    return a;
}
__device__ __forceinline__ void phase_fixup(const Params& p, const float* cw, const float* cb) {
    bf16_t* ACT = (bf16_t*)(p.ws + OFF_R + R_ACT); const float* HALO = (const float*)(p.ws + OFF_R + R_HALO);
    const int gt = blockIdx.x * NTHREADS + otid(), NGT = gridDim.x * NTHREADS;
    constexpr int NG = FF / 4;
    for (int id = gt; id < (T_ / 256) * NG; id += NGT) {
        const int tile = id / NG, blk = 4 * tile, ch = (id - tile * NG) * 4, cpg = (ch >> 7) * 256 + (ch & 127);
        const f32x4 z = {0.f, 0.f, 0.f, 0.f};
        const bool prev = (blk & 63) != 0;
        const float* hp = HALO + (size_t)(blk - 1) * 4 * NUP + cpg; const float* hc = HALO + (size_t)blk * 4 * NUP + cpg;
        const f32x4 g_m2 = prev ? *(const f32x4*)(hp) : z, g_m1 = prev ? *(const f32x4*)(hp + NUP) : z, g_0 = *(const f32x4*)(hc + 2 * NUP), g_1 = *(const f32x4*)(hc + 3 * NUP);
        const f32x4 u_m2 = prev ? *(const f32x4*)(hp + 128) : z, u_m1 = prev ? *(const f32x4*)(hp + NUP + 128) : z, u_0 = *(const f32x4*)(hc + 2 * NUP + 128), u_1 = *(const f32x4*)(hc + 3 * NUP + 128);
        const f32x4 wg0 = *(const f32x4*)(cw + ch), wg1 = *(const f32x4*)(cw + NUP + ch), wg2 = *(const f32x4*)(cw + 2 * NUP + ch), bg = *(const f32x4*)(cb + ch);
        const f32x4 wu0 = *(const f32x4*)(cw + FF + ch), wu1 = *(const f32x4*)(cw + NUP + FF + ch), wu2 = *(const f32x4*)(cw + 2 * NUP + FF + ch), bu = *(const f32x4*)(cb + FF + ch);
        const f32x4 a0 = silu_mul(wg0 * g_m2 + wg1 * g_m1 + wg2 * g_0 + bg, wu0 * u_m2 + wu1 * u_m1 + wu2 * u_0 + bu);
        const f32x4 a1 = silu_mul(wg0 * g_m1 + wg1 * g_0 + wg2 * g_1 + bg, wu0 * u_m1 + wu1 * u_0 + wu2 * u_1 + bu);
        u32x2 w; w.x = pk2(a0[0], a0[1]); w.y = pk2(a0[2], a0[3]); *(u32x2*)(ACT + (size_t)(blk * 64) * FF + ch) = w;
        w.x = pk2(a1[0], a1[1]); w.y = pk2(a1[2], a1[3]); *(u32x2*)(ACT + (size_t)(blk * 64 + 1) * FF + ch) = w;
    }
}

__device__ __forceinline__ void phase_rope(const Params& p) {
    bf16_t* QKV = (bf16_t*)(p.ws + OFF_R + R_BIG); const float* COS = (const float*)(p.ws + OFF_ROPE); const float* SIN = COS + T_ * 16;
    const int gt = blockIdx.x * NTHREADS + otid(), NGT = gridDim.x * NTHREADS;
    for (int id = gt; id < T_ * 32; id += NGT) {
        const int t = id >> 5, grp = id & 31;
        bf16_t* base = QKV + (size_t)t * N6 + grp * 128;
        float x1[16], x2[16], c[16], s[16];
        { float tmp[8]; unpack8(*(const u32x4*)(base), tmp);
#pragma unroll
          for (int k = 0; k < 8; ++k) x1[k] = tmp[k];
          unpack8(*(const u32x4*)(base + 8), tmp);
#pragma unroll
          for (int k = 0; k < 8; ++k) x1[8 + k] = tmp[k];
          unpack8(*(const u32x4*)(base + 16), tmp);
#pragma unroll
          for (int k = 0; k < 8; ++k) x2[k] = tmp[k];
          unpack8(*(const u32x4*)(base + 24), tmp);
#pragma unroll
          for (int k = 0; k < 8; ++k) x2[8 + k] = tmp[k]; }
#pragma unroll
        for (int q = 0; q < 4; ++q) { const f32x4 cc = *(const f32x4*)(COS + t * 16 + 4 * q), ss = *(const f32x4*)(SIN + t * 16 + 4 * q);
#pragma unroll
            for (int k = 0; k < 4; ++k) { c[4 * q + k] = cc[k]; s[4 * q + k] = ss[k]; } }
        float n1[16], n2[16];
#pragma unroll
        for (int k = 0; k < 16; ++k) { n1[k] = x1[k] * c[k] - x2[k] * s[k]; n2[k] = x2[k] * c[k] + x1[k] * s[k]; }
        u32x4 o;
        o.x = pk2(n1[0], n1[1]); o.y = pk2(n1[2], n1[3]); o.z = pk2(n1[4], n1[5]); o.w = pk2(n1[6], n1[7]); *(u32x4*)(base) = o;
        o.x = pk2(n1[8], n1[9]); o.y = pk2(n1[10], n1[11]); o.z = pk2(n1[12], n1[13]); o.w = pk2(n1[14], n1[15]); *(u32x4*)(base + 8) = o;
        o.x = pk2(n2[0], n2[1]); o.y = pk2(n2[2], n2[3]); o.z = pk2(n2[4], n2[5]); o.w = pk2(n2[6], n2[7]); *(u32x4*)(base + 16) = o;
        o.x = pk2(n2[8], n2[9]); o.y = pk2(n2[10], n2[11]); o.z = pk2(n2[12], n2[13]); o.w = pk2(n2[14], n2[15]); *(u32x4*)(base + 24) = o;
    }
}

typedef att::BlockRef<att::bf16, att::bf16> ABlock;
__device__ __forceinline__ ABlock attn_ref(const att::bf16* QKV, att::bf16* AO0, att::bf16* AO1, int L, int pass) {
    const int i = L >> 8, wl = L & 255, bh = i * 8 + (wl & 7), sub = wl >> 3, c = sub >> 4, e = (sub >> 3) & 1, x = sub & 7;
    const int b = bh >> 3, h = bh & 7, qb = pass ? 15 - x : x;
    ABlock r;
    const size_t row0 = (size_t)b * SEQ;
    r.Q = QKV + (row0 + (size_t)qb * 256) * N6 + h * 256 + c * 128;
    r.K = QKV + row0 * N6 + DM + h * 256 + c * 128;
    r.V = QKV + row0 * N6 + 2 * DM + h * 256 + e * 128;
    r.O = (c ? AO1 : AO0) + (row0 + (size_t)qb * 256) * DM + h * 256 + e * 128;
    r.P0 = qb * 256;
    return r;
}
__device__ __forceinline__ void phase_attn(const Params& p, char* lds) {
    const att::bf16* QKV = (const att::bf16*)(p.ws + OFF_R + R_BIG); att::bf16* AO0 = (att::bf16*)(p.ws + OFF_R + R_SMALL); att::bf16* AO1 = (att::bf16*)(p.ws + OFF_XB);
    constexpr int TOTAL = 1024; const int stride = gridDim.x;
    int L = blockIdx.x; if (L >= TOTAL) return;
    int pass = 0;
    ABlock cur = attn_ref(QKV, AO0, AO1, L, 0);
    att::Seam<att::bf16> S;
    att::causal_swa_prime<att::bf16, att::bf16>(cur, SEQ, lds, S);
    for (;;) {
        const bool more_pass = pass == 0, more_item = L + stride < TOTAL, last = !more_pass && !more_item;
        int passn = pass + 1, Ln = L;
        if (!more_pass) { passn = 0; Ln = more_item ? L + stride : L; }
        const ABlock nxt = last ? cur : attn_ref(QKV, AO0, AO1, Ln, passn);
        att::causal_swa_block<att::bf16, att::bf16>(cur, nxt, SEQ, SEQ, lds, S);
        if (last) break;
        cur = nxt; pass = passn; L = Ln;
    }
}

__device__ __forceinline__ void phase_combine(const Params& p) {
    bf16_t* AO0 = (bf16_t*)(p.ws + OFF_R + R_SMALL); const bf16_t* AO1 = (const bf16_t*)(p.ws + OFF_XB);
    const int lane = otid() & 63, gw = blockIdx.x * 8 + (otid() >> 6), NGW = gridDim.x * 8;
    const float s01 = wave_sum(p.lam[lane] * p.lam[128 + lane] + p.lam[64 + lane] * p.lam[192 + lane], lane);
    const float s23 = wave_sum(p.lam[256 + lane] * p.lam[384 + lane] + p.lam[320 + lane] * p.lam[448 + lane], lane);
    const float lam = __builtin_amdgcn_exp2f(1.4426950408889634f * s01) - __builtin_amdgcn_exp2f(1.4426950408889634f * s23) + LAMBDA_INIT;
    float gs[8];
    { const f32x4 a = *(const f32x4*)(p.subln_g + (lane & 31) * 8), b = *(const f32x4*)(p.subln_g + (lane & 31) * 8 + 4);
      gs[0] = a[0]; gs[1] = a[1]; gs[2] = a[2]; gs[3] = a[3]; gs[4] = b[0]; gs[5] = b[1]; gs[6] = b[2]; gs[7] = b[3];
#pragma unroll
      for (int k = 0; k < 8; ++k) gs[k] *= (1.0f - LAMBDA_INIT); }
    constexpr int RPI = 4;
    for (int row0 = gw * RPI; row0 < T_; row0 += NGW * RPI) {
        u32x4 va[RPI][4], vb[RPI][4];
#pragma unroll
        for (int r = 0; r < RPI; ++r) { const u32x4* r0 = (const u32x4*)(AO0 + (size_t)(row0 + r) * DM) + lane; const u32x4* r1 = (const u32x4*)(AO1 + (size_t)(row0 + r) * DM) + lane;
#pragma unroll
            for (int j = 0; j < 4; ++j) { va[r][j] = r0[64 * j]; vb[r][j] = r1[64 * j]; } }
#pragma unroll
        for (int r = 0; r < RPI; ++r) { u32x4* r0 = (u32x4*)(AO0 + (size_t)(row0 + r) * DM) + lane;
#pragma unroll
            for (int j = 0; j < 4; ++j) {
                float a[8], b[8], o[8]; unpack8(va[r][j], a); unpack8(vb[r][j], b);
                float ss = 0.f;
#pragma unroll
                for (int k = 0; k < 8; ++k) { o[k] = a[k] - lam * b[k]; ss += o[k] * o[k]; }
                ss = xadd<1>(ss, lane); ss = xadd<2>(ss, lane); ss = xadd<4>(ss, lane); ss = xadd<8>(ss, lane); ss = xadd<16>(ss, lane);
                const float rstd = 1.f / sqrtf(ss * (1.f / 256.f) + SUBLN_EPS);
                u32x4 w; w.x = pk2(o[0] * rstd * gs[0], o[1] * rstd * gs[1]); w.y = pk2(o[2] * rstd * gs[2], o[3] * rstd * gs[3]);
                w.z = pk2(o[4] * rstd * gs[4], o[5] * rstd * gs[5]); w.w = pk2(o[6] * rstd * gs[6], o[7] * rstd * gs[7]);
                r0[64 * j] = w;
            } }
    }
}

#define XB_TMO      128
#define XB_XCNT(j)  (256  + 64 * (j))
#define XB_XSUB(j)  (1280 + 64 * (j))
#define XB_XGEN(j)  (2304 + 64 * (j))
#define XB_TOP      3328
#define XB_TOPGEN   3392
#define XCD_BAR_WORDS 3456
#define XB_SPIN_CAP (1u << 18)
__device__ __forceinline__ unsigned xb_ld(unsigned* p)              { return __hip_atomic_load(p, __ATOMIC_RELAXED, __HIP_MEMORY_SCOPE_AGENT); }
__device__ __forceinline__ unsigned xb_add(unsigned* p, unsigned v) { return __hip_atomic_fetch_add(p, v, __ATOMIC_RELAXED, __HIP_MEMORY_SCOPE_AGENT); }
__device__ __forceinline__ unsigned xb_xcc_id() { return (unsigned)__builtin_amdgcn_s_getreg((3 << 11) | 20) & 0xFu; }
#define XB_SPIN(cond, bar) do { unsigned _sp = 0; while (cond) { __builtin_amdgcn_s_sleep(1); \
    if ((++_sp & 255u) == 0u) { if (xb_ld(&(bar)[XB_TMO])) break; if (_sp > XB_SPIN_CAP) { atomicAdd(&(bar)[XB_TMO], 1u); break; } } } } while (0)

struct XcdBarrier {
    unsigned* bar; unsigned x;
    volatile LAS unsigned* st;
};

__device__ __forceinline__ XcdBarrier xcd_barrier_post(unsigned* bar, volatile LAS unsigned* st) {
    XcdBarrier b; b.bar = bar; b.x = xb_xcc_id(); b.st = st;
    if (otid() == 0) (void)xb_add(&bar[XB_XCNT(b.x)], 1u);
    return b;
}
__device__ __forceinline__ void xcd_barrier_complete(unsigned* bar, unsigned x, unsigned& nloc, unsigned& nx) {
    const unsigned G = gridDim.x * gridDim.y * gridDim.z;
    unsigned sum, cnt, mine, sp = 0u;
    for (;;) {
        sum = 0u; cnt = 0u; mine = 0u;
#pragma unroll
        for (unsigned j = 0; j < 16; ++j) { const unsigned c = xb_ld(&bar[XB_XCNT(j)]); sum += c; cnt += (c > 0u) ? 1u : 0u; mine = (j == x) ? c : mine; }
        if (sum == G) break;
        __builtin_amdgcn_s_sleep(1);
        if ((++sp & 255u) == 0u) { if (xb_ld(&bar[XB_TMO])) break; if (sp > XB_SPIN_CAP) { atomicAdd(&bar[XB_TMO], 1u); break; } }
    }
    nloc = mine > 0u ? mine : 1u; nx = cnt > 0u ? cnt : 1u;
}

__device__ __forceinline__ void xcd_barrier(const XcdBarrier& b) {
    asm volatile("s_waitcnt vmcnt(0)" ::: "memory");
    __syncthreads();
    if (otid() == 0) {
        unsigned* bar = b.bar;
        __builtin_amdgcn_s_waitcnt(0);
        unsigned nloc = b.st[0], nx = b.st[1];
        if (nloc == 0u) { xcd_barrier_complete(bar, b.x, nloc, nx); b.st[0] = nloc; b.st[1] = nx; }
        const unsigned old = xb_add(&bar[XB_XSUB(b.x)], 1u);
        const unsigned gen = old / nloc;
        if (old + 1u == (gen + 1u) * nloc) {
            __builtin_amdgcn_fence(__ATOMIC_RELEASE, "agent");
            asm volatile("s_waitcnt vmcnt(0)" ::: "memory");
            const unsigned og = xb_add(&bar[XB_TOP], 1u);
            const unsigned tg = og / nx;
            if (og + 1u == (tg + 1u) * nx) xb_add(&bar[XB_TOPGEN], 1u);
            else XB_SPIN(xb_ld(&bar[XB_TOPGEN]) == tg, bar);
            __builtin_amdgcn_fence(__ATOMIC_ACQUIRE, "agent");
            xb_add(&bar[XB_XGEN(b.x)], 1u);
            asm volatile("s_waitcnt vmcnt(0)" ::: "memory");
        } else {
            XB_SPIN(xb_ld(&bar[XB_XGEN(b.x)]) == gen, bar);
            __builtin_amdgcn_fence(__ATOMIC_ACQUIRE, "agent");
            asm volatile("s_waitcnt vmcnt(0)" ::: "memory");
        }
    }
    __syncthreads();
}

template <int layer>
__device__ __forceinline__ void layer_body(const Params& p, LAS unsigned char* ldsl, unsigned char* lds, const XcdBarrier& bar, const int G, const int c) {
        unsigned char* ws = p.ws; float* Z = (float*)(ws + OFF_Z); bf16_t* XB = (bf16_t*)(ws + OFF_XB);
        if constexpr (layer == 0) {
            { pg8::Gemm g{XB, (const bf16_t*)(ws + OFF_WIN), T_, 2 * DM, DM}; pg8::StaticOrder S; S.init(T_, 2 * DM, G, c);
              pg8::EpiGateCV E{(bf16_t*)(ws + OFF_R + R_BIG), (bf16_t*)(ws + OFF_R + R_BIG) + (size_t)T_ * DM};
              pg8::gemm_phase<pg8::EpiGateCV, pg8::StaticOrder, PG8_ALIGN, PG8_SP2>(ldsl, g, S, E); }
            xcd_barrier(bar);
            { pg8::Gemm g{XB, (const bf16_t*)(ws + OFF_WIN) + (size_t)2 * DM * DM, T_, DM, DM}; pg8::StaticOrder S; S.init(T_, DM, G, c);
              pg8::EpiMix E{(const bf16_t*)(ws + OFF_R + R_BIG) + (size_t)T_ * DM, (bf16_t*)(ws + OFF_R + R_SMALL), p.a_conv_w};
              pg8::gemm_phase<pg8::EpiMix, pg8::StaticOrder, PG8_ALIGN, PG8_SP2>(ldsl, g, S, E); }
            xcd_barrier(bar);
        } else {
            { pg8::Gemm g{XB, (const bf16_t*)(ws + OFF_WQKV), T_, N6, DM}; pg8::StaticOrder S; S.init(T_, N6, G, c);
              pg8::EpiBf16P E{(bf16_t*)(ws + OFF_R + R_BIG), N6, (const float*)(ws + OFF_ROPE), (const float*)(ws + OFF_ROPE) + T_ * 16};
              pg8::gemm_phase<pg8::EpiBf16P, pg8::StaticOrder, PG8_ALIGN, PG8_SP2>(ldsl, g, S, E); }
            xcd_barrier(bar);
            phase_attn(p, (char*)lds); xcd_barrier(bar); phase_combine(p); xcd_barrier(bar);
        }
        { pg8::Gemm g{(const bf16_t*)(ws + OFF_R + R_SMALL), (const bf16_t*)(ws + (layer ? OFF_WO : OFF_WOUT)), T_, DM, DM}; pg8::StaticOrder S; S.init(T_, DM, G, c);
          pg8::EpiResF32 E{layer ? (const float*)Z : p.x, Z, DM, ALPHA, layer ? (const float*)LNST(1) : nullptr, p.ln_g + DM, p.ln_b + DM};
          pg8::gemm_phase<pg8::EpiResF32, pg8::StaticOrder, PG8_ALIGN, PG8_SP2>(ldsl, g, S, E); }
        xcd_barrier(bar);
        phase_ln(Z, nullptr, XB, p.ln_g + (size_t)(layer * 2) * DM, p.ln_b + (size_t)(layer * 2) * DM, LNST(layer * 2));
        xcd_barrier(bar);
        const float* cw = p.ffn_cw + (size_t)layer * 3 * NUP; const float* cb = p.ffn_cb + (size_t)layer * NUP;
        { pg8::Gemm g{XB, (const bf16_t*)(ws + (layer ? OFF_WUP1 : OFF_WUP0)), T_, NUP, DM}; pg8::StaticOrder S; S.init(T_, NUP, G, c);
          pg8::EpiConvGate E{(bf16_t*)(ws + OFF_R + R_ACT), (float*)(ws + OFF_R + R_HALO), cw, cb};
          pg8::gemm_phase<pg8::EpiConvGate, pg8::StaticOrder, PG8_ALIGN, PG8_SP2>(ldsl, g, S, E); }
        xcd_barrier(bar);
        phase_fixup(p, cw, cb);
        xcd_barrier(bar);
        { pg8::Gemm g{(const bf16_t*)(ws + OFF_R + R_ACT), (const bf16_t*)(ws + (layer ? OFF_WDN1 : OFF_WDN0)), T_, DM, FF}; pg8::StaticOrder S; S.init(T_, DM, G, c);
          pg8::EpiResF32 E{Z, Z, DM, ALPHA, LNST(layer * 2), p.ln_g + (size_t)(layer * 2) * DM, p.ln_b + (size_t)(layer * 2) * DM};
          pg8::gemm_phase<pg8::EpiResF32, pg8::StaticOrder, PG8_ALIGN, PG8_SP2>(ldsl, g, S, E); }
        xcd_barrier(bar);
        phase_ln(Z, layer ? p.out : nullptr, layer ? nullptr : XB, p.ln_g + (size_t)(layer * 2 + 1) * DM, p.ln_b + (size_t)(layer * 2 + 1) * DM, layer ? nullptr : LNST(1));
        if (layer == 0) xcd_barrier(bar);
    }

__global__ void __launch_bounds__(NTHREADS, 2) fwd_megakernel(Params p) {
    extern __shared__ __attribute__((aligned(16))) unsigned char lds[];
    cg::grid_group grid = cg::this_grid();
    LAS unsigned char* ldsl = (LAS unsigned char*)lds;
    unsigned char* ws = p.ws;
    float* Z = (float*)(ws + OFF_Z); bf16_t* XB = (bf16_t*)(ws + OFF_XB);
    const int G = gridDim.x, c = blockIdx.x;

    volatile LAS unsigned* st = (volatile LAS unsigned*)(ldsl + LDS_STAGE);
    { const int t0 = threadIdx.x; if ((t0 & 63) == 0) ((volatile LAS int*)(ldsl + WTAB_OFF))[hwslot()] = t0 >> 6; if (t0 < 4) st[t0] = 0u; }
    __syncthreads();
    const XcdBarrier bar = xcd_barrier_post((unsigned*)(ws + OFF_BAR), st);
    phase_prologue(p, ldsl);
    if (gridDim.x == 0x7fffffffu) grid.sync();
    xcd_barrier(bar);
    layer_body<0>(p, ldsl, lds, bar, G, c);
    layer_body<1>(p, ldsl, lds, bar, G, c);
}

extern "C" void kernel_launch(void* const* d_in, const int* in_sizes, int n_in, void* d_out, int out_size, void* d_ws, size_t ws_size, hipStream_t stream) {
    static int grid = 0;
    if (grid == 0) {
        if (n_in != 17 || in_sizes[0] != T_ * DM || out_size != T_ * DM || ws_size < WS_END) {
            fprintf(stderr, "kernel_launch: unexpected shapes (n_in %d, in0 %d, out %d, ws %zu, need %zu)\n", n_in, n_in > 0 ? in_sizes[0] : -1, out_size, ws_size, (size_t)WS_END); grid = -1; return; }
        int dev = 0, cus = 0, per_cu = 0;
        (void)hipGetDevice(&dev); (void)hipDeviceGetAttribute(&cus, hipDeviceAttributeMultiprocessorCount, dev);
        if (hipFuncSetAttribute((const void*)fwd_megakernel, hipFuncAttributeMaxDynamicSharedMemorySize, LDS_BYTES) != hipSuccess) { fprintf(stderr, "kernel_launch: hipFuncSetAttribute failed\n"); grid = -1; return; }
        if (hipOccupancyMaxActiveBlocksPerMultiprocessor(&per_cu, (const void*)fwd_megakernel, NTHREADS, LDS_BYTES) != hipSuccess || per_cu < 1) { fprintf(stderr, "kernel_launch: occupancy query says %d\n", per_cu); per_cu = 1; }
        (void)hipGetLastError();
        if (cus <= 0) cus = 256;
        grid = cus;
    }
    if (grid < 0) return;
    Params p{};
    p.x = (const float*)d_in[0]; p.pos = (const int*)d_in[1]; p.ln_g = (const float*)d_in[2]; p.ln_b = (const float*)d_in[3];
    p.a_w_in = (const float*)d_in[4]; p.a_conv_w = (const float*)d_in[5]; p.a_w_out = (const float*)d_in[6];
    p.w_k = (const float*)d_in[7]; p.w_v = (const float*)d_in[8]; p.w_q = (const float*)d_in[9]; p.lam = (const float*)d_in[10];
    p.subln_g = (const float*)d_in[11]; p.w_o = (const float*)d_in[12]; p.w_up = (const float*)d_in[13]; p.ffn_cw = (const float*)d_in[14];
    p.ffn_cb = (const float*)d_in[15]; p.w_dn = (const float*)d_in[16];
    p.out = (float*)d_out; p.ws = (unsigned char*)d_ws;
    (void)hipMemsetAsync((unsigned char*)d_ws + OFF_BAR, 0, XCD_BAR_WORDS * 4, stream);
    void* args[] = {&p};
    hipError_t e = hipLaunchCooperativeKernel((const void*)fwd_megakernel, dim3(grid), dim3(NTHREADS), args, LDS_BYTES, stream);
    if (e != hipSuccess) fprintf(stderr, "kernel_launch: cooperative launch failed: %s (grid %d)\n", hipGetErrorString(e), grid);
}
```
